# Optimizing an MI355X kernel written in HIP

```python
import math
import jax, jax.numpy as jnp
from jax import lax
import numpy as np


D_MODEL = 2048
BATCH = 4
SEQ = 2048
DEPTH = 2

PLE_DIM = 256
NORM_EPS = 1e-6
POOL_WIDTH = D_MODEL // 2
POOL_WINDOWS = (2, 4, 8, 16)
POOL_GROUP = POOL_WIDTH // len(POOL_WINDOWS)
HYENA_WIDTH = D_MODEL // 2
HYENA_ORDER = 2
N_DIRS = 2
SHORT_CONV = 3
FILTER_EMB = 33
FILTER_HIDDEN = 64
DECAY_TARGET = 1e-2
DECAY_SHORT_PCT = 0.3
DECAY_LONG_PCT = 1.5
DECAY_MIN = math.log(DECAY_TARGET) / DECAY_LONG_PCT
DECAY_MAX = math.log(DECAY_TARGET) / DECAY_SHORT_PCT
IN_COLS = POOL_WIDTH + (HYENA_ORDER + 1) * HYENA_WIDTH + 2 * D_MODEL
PEER_HEADS = 8
PEER_NKEYS = 128
PEER_N = PEER_NKEYS * PEER_NKEYS
PEER_QDIM = 256
PEER_HALF = PEER_QDIM // 2
PEER_TOPK = 16
PEER_CHUNK = 128

kernel_name = 'hybrid_pool_hyena_peer_encoder'


def _rms_norm(x, g):
    xf = x.astype(jnp.float32)
    y = xf * lax.rsqrt(jnp.mean(xf * xf, axis=-1, keepdims=True) + NORM_EPS)
    return (y * g.astype(jnp.float32)).astype(x.dtype)


def _short_conv(u, w, b):
    L = u.shape[1]
    pad = SHORT_CONV // 2
    up = jnp.pad(u, ((0, 0), (pad, SHORT_CONV - 1 - pad), (0, 0)))
    return sum(up[:, k:k + L] * w[k] for k in range(SHORT_CONV)) + b


def _multiscale_pool(u, pool_w, pool_scale):
    B, L, C = u.shape
    csum = jnp.cumsum(u.astype(jnp.float32), axis=1)
    csum = jnp.concatenate([jnp.zeros((B, 1, C), jnp.float32), csum], axis=1)
    pos = jnp.arange(L)
    outs = []
    for gi, win in enumerate(POOL_WINDOWS):
        lo = jnp.clip(pos - win // 2, 0, L - 1)
        hi = jnp.clip(pos + win - win // 2 - 1, 0, L - 1)
        cg = csum[..., gi * POOL_GROUP:(gi + 1) * POOL_GROUP]
        ug = u[..., gi * POOL_GROUP:(gi + 1) * POOL_GROUP].astype(jnp.float32)
        count = (hi - lo + 1).astype(jnp.float32)[None, :, None]
        mean = (cg[:, hi + 1] - cg[:, lo]) / count
        outs.append((mean - ug).astype(u.dtype) @ pool_w[gi])
    return jnp.concatenate(outs, axis=-1) * pool_scale


def _hyena_filters(L, w1, b1, w2, b2, w3, freq):
    f32 = jnp.float32
    t = jnp.linspace(0.0, 1.0, L, dtype=f32)[:, None]
    bands = (FILTER_EMB - 1) // 2
    fb = jnp.linspace(1e-4, bands - 1, bands, dtype=f32)[None, :]
    ang = (2.0 * math.pi / L) * jnp.arange(L, dtype=f32)[:, None] * fb
    z = jnp.concatenate([t, jnp.cos(ang), -jnp.sin(ang)], axis=-1)
    fr = freq.astype(f32)
    hdn = jnp.sin(fr * (z @ w1.astype(f32) + b1.astype(f32)))
    hdn = jnp.sin(fr * (hdn @ w2.astype(f32) + b2.astype(f32)))
    filt = (hdn @ w3.astype(f32)).reshape(L, N_DIRS, HYENA_ORDER, HYENA_WIDTH)
    deltas = jnp.abs(jnp.linspace(DECAY_MIN, DECAY_MAX, HYENA_WIDTH, dtype=f32))
    filt = filt * jnp.exp(-t.reshape(L, 1, 1, 1) * deltas)
    return filt / (jnp.sum(jnp.abs(filt), axis=0, keepdims=True) + 1e-6)


def _bidir_long_conv(u, h_dirs, bias):
    L = u.shape[1]
    n = 2 * L
    uf = u.astype(jnp.float32)
    U = jnp.fft.rfft(uf, n=n, axis=1)
    H = jnp.fft.rfft(h_dirs, n=n, axis=0)
    Hc = H[:, 0] + jnp.conj(H[:, 1])
    y = jnp.fft.irfft(U * Hc[None], n=n, axis=1)[:, :L]
    return (y + uf * bias.astype(jnp.float32)).astype(u.dtype)


def _hyena(proj, conv_w, conv_b, filt, filt_bias):
    uc = _short_conv(proj, conv_w, conv_b)
    v, x1, x2 = jnp.split(uc, HYENA_ORDER + 1, axis=-1)
    z = _bidir_long_conv(v, filt[:, :, 0], filt_bias[0]) * x1
    z = _bidir_long_conv(z, filt[:, :, 1], filt_bias[1]) * x2
    return z


def _peer(xn, wq, k1, k2, u_tab, v_tab):
    B, S, D = xn.shape
    T = B * S
    xt = xn.reshape(T, D)
    q = (xt @ wq).reshape(T, PEER_HEADS, PEER_QDIM).astype(jnp.float32)
    s1 = jnp.einsum('thd,kd->thk', q[..., :PEER_HALF], k1.astype(jnp.float32))
    s2 = jnp.einsum('thd,kd->thk', q[..., PEER_HALF:], k2.astype(jnp.float32))
    v1, i1 = lax.top_k(s1, PEER_TOPK)
    v2, i2 = lax.top_k(s2, PEER_TOPK)
    cand = (v1[..., :, None] + v2[..., None, :]).reshape(T, PEER_HEADS, PEER_TOPK * PEER_TOPK)
    cand_idx = (i1[..., :, None] * PEER_NKEYS + i2[..., None, :]).reshape(T, PEER_HEADS, PEER_TOPK * PEER_TOPK)
    best, sel = lax.top_k(cand, PEER_TOPK)
    idx = jnp.take_along_axis(cand_idx, sel, axis=-1).reshape(T, PEER_HEADS * PEER_TOPK)
    gate = jax.nn.softmax(best, axis=-1).reshape(T, PEER_HEADS * PEER_TOPK).astype(xn.dtype)
    nc = T // PEER_CHUNK

    def chunk_fn(args):
        xc, ic, gc = args
        hid = jnp.einsum('cd,ced->ce', xc, u_tab[ic])
        act = gc * jax.nn.gelu(hid, approximate=False)
        return jnp.einsum('ce,ced->cd', act, v_tab[ic])

    out = lax.map(chunk_fn, (xt.reshape(nc, PEER_CHUNK, D),
                             idx.reshape(nc, PEER_CHUNK, -1),
                             gate.reshape(nc, PEER_CHUNK, -1)))
    return out.reshape(B, S, D)


def setup_inputs(seed: int = 0) -> dict:
    key = jax.random.key(seed)
    ks = jax.random.split(key, 32)
    f32 = jnp.float32

    def nrm(k, shape, scale):
        return jax.random.normal(k, shape, f32) * scale

    def gain(k, shape):
        return 1.0 + 0.02 * jax.random.normal(k, shape, f32)

    return {
        'x': nrm(ks[0], (BATCH, SEQ, D_MODEL), 1.0),
        'p': nrm(ks[1], (DEPTH, BATCH, SEQ, PLE_DIM), 1.0),
        'norm_mix_g': gain(ks[2], (DEPTH, D_MODEL)),
        'w_in': nrm(ks[3], (DEPTH, D_MODEL, IN_COLS), D_MODEL ** -0.5),
        'pool_w': nrm(ks[4], (DEPTH, len(POOL_WINDOWS), POOL_GROUP, POOL_GROUP), POOL_GROUP ** -0.5),
        'pool_scale': gain(ks[5], (DEPTH, POOL_WIDTH)),
        'w_pool_out': nrm(ks[6], (DEPTH, POOL_WIDTH, D_MODEL), POOL_WIDTH ** -0.5),
        'short_conv_w': nrm(ks[7], (DEPTH, SHORT_CONV, (HYENA_ORDER + 1) * HYENA_WIDTH), SHORT_CONV ** -0.5),
        'short_conv_b': nrm(ks[8], (DEPTH, (HYENA_ORDER + 1) * HYENA_WIDTH), 0.02),
        'filt_w1': nrm(ks[9], (DEPTH, FILTER_EMB, FILTER_HIDDEN), FILTER_EMB ** -0.5),
        'filt_b1': nrm(ks[10], (DEPTH, FILTER_HIDDEN), 0.1),
        'filt_w2': nrm(ks[11], (DEPTH, FILTER_HIDDEN, FILTER_HIDDEN), FILTER_HIDDEN ** -0.5),
        'filt_b2': nrm(ks[12], (DEPTH, FILTER_HIDDEN), 0.1),
        'filt_w3': nrm(ks[13], (DEPTH, FILTER_HIDDEN, N_DIRS * HYENA_ORDER * HYENA_WIDTH), FILTER_HIDDEN ** -0.5),
        'filt_freq': gain(ks[14], (DEPTH, FILTER_HIDDEN)),
        'filt_bias': nrm(ks[15], (DEPTH, HYENA_ORDER, HYENA_WIDTH), 0.1),
        'w_hyena_out': nrm(ks[16], (DEPTH, HYENA_WIDTH, D_MODEL), HYENA_WIDTH ** -0.5),
        'w_o': nrm(ks[17], (DEPTH, D_MODEL, D_MODEL), D_MODEL ** -0.5),
        'norm_ffn_g': gain(ks[18], (DEPTH, D_MODEL)),
        'peer_wq': nrm(ks[19], (DEPTH, D_MODEL, PEER_HEADS * PEER_QDIM), D_MODEL ** -0.5),
        'peer_k1': nrm(ks[20], (DEPTH, PEER_NKEYS, PEER_HALF), PEER_HALF ** -0.5),
        'peer_k2': nrm(ks[21], (DEPTH, PEER_NKEYS, PEER_HALF), PEER_HALF ** -0.5),
        'peer_u': nrm(ks[22], (DEPTH, PEER_N, D_MODEL), D_MODEL ** -0.5),
        'peer_v': nrm(ks[23], (DEPTH, PEER_N, D_MODEL), PEER_HEADS ** -0.5),
        'norm_ple_g': gain(ks[24], (DEPTH, D_MODEL)),
        'ple_w_gate': nrm(ks[25], (DEPTH, D_MODEL, D_MODEL), D_MODEL ** -0.5),
        'ple_w_proj': nrm(ks[26], (DEPTH, PLE_DIM, D_MODEL), PLE_DIM ** -0.5),
        'final_norm_g': gain(ks[27], (D_MODEL,)),
    }


def reference(x, p, norm_mix_g, w_in, pool_w, pool_scale, w_pool_out, short_conv_w, short_conv_b,
              filt_w1, filt_b1, filt_w2, filt_b2, filt_w3, filt_freq, filt_bias, w_hyena_out, w_o,
              norm_ffn_g, peer_wq, peer_k1, peer_k2, peer_u, peer_v, norm_ple_g, ple_w_gate,
              ple_w_proj, final_norm_g):
    h = x
    L = x.shape[1]
    split_hy = POOL_WIDTH
    split_gate = POOL_WIDTH + (HYENA_ORDER + 1) * HYENA_WIDTH
    for i in range(DEPTH):
        xn = _rms_norm(h, norm_mix_g[i])
        proj = xn @ w_in[i]
        pool_in = proj[..., :split_hy]
        hy_in = proj[..., split_hy:split_gate]
        g_pool, g_hy = jnp.split(jax.nn.sigmoid(proj[..., split_gate:]), 2, axis=-1)
        a = _multiscale_pool(pool_in, pool_w[i], pool_scale[i]) @ w_pool_out[i]
        filt = _hyena_filters(L, filt_w1[i], filt_b1[i], filt_w2[i], filt_b2[i], filt_w3[i], filt_freq[i])
        b = _hyena(hy_in, short_conv_w[i], short_conv_b[i], filt, filt_bias[i]) @ w_hyena_out[i]
        h = h + (g_pool * a + g_hy * b) @ w_o[i]
        hn = _rms_norm(h, norm_ffn_g[i])
        h = h + _peer(hn, peer_wq[i], peer_k1[i], peer_k2[i], peer_u[i], peer_v[i])
        hn = _rms_norm(h, norm_ple_g[i])
        h = h + jax.nn.sigmoid(hn @ ple_w_gate[i]) * (p[i] @ ple_w_proj[i])
    return _rms_norm(h, final_norm_g)
```

```cpp
#include <hip/hip_runtime.h>
#include <cstdio>
#include <cstdint>

#ifndef MK_ONE_LAUNCH
#define MK_ONE_LAUNCH 0
#endif

#define LAS __attribute__((address_space(3)))
#define HD __host__ __device__ __forceinline__
#define DEV __device__ __forceinline__

typedef unsigned short bf16_t;
typedef short bf16x8 __attribute__((ext_vector_type(8)));
typedef float f32x4 __attribute__((ext_vector_type(4)));
typedef unsigned u32x4 __attribute__((ext_vector_type(4)));
typedef unsigned u32x2 __attribute__((ext_vector_type(2)));

constexpr int T_ = 8192, D_ = 2048, L_ = 2048, NB_ = 4, DEPTH_ = 2;
constexpr int PLE_ = 256, INC_ = 8192, HW_ = 1024, PW_ = 1024;
constexpr int NEXP_ = 16384;
constexpr float EPS_ = 1e-6f;
constexpr int NTHREADS = 512, NWAVES = 8;
constexpr int LDS_BYTES = 147456;

constexpr size_t MiB = 1ull << 20;
constexpr size_t WS_CTL    = 0;
constexpr size_t WS_WIN_T  = 1 * MiB;
constexpr size_t WS_WPOOL  = WS_WIN_T + 64 * MiB;
constexpr size_t WS_WPO_T  = WS_WPOOL + 1 * MiB;
constexpr size_t WS_WHO_T  = WS_WPO_T + 8 * MiB;
constexpr size_t WS_WO_T   = WS_WHO_T + 8 * MiB;
constexpr size_t WS_WQ_T   = WS_WO_T + 16 * MiB;
constexpr size_t WS_WG_T   = WS_WQ_T + 16 * MiB;
constexpr size_t WS_WP_T   = WS_WG_T + 16 * MiB;
constexpr size_t WS_KBD    = WS_WP_T + 2 * MiB;
constexpr size_t WS_HB     = WS_KBD + 1 * MiB;
constexpr size_t WS_W3A    = WS_HB + 2 * MiB;
constexpr size_t WS_P16    = WS_W3A + 4 * MiB;
constexpr size_t WS_U16    = WS_P16 + 8 * MiB;
constexpr size_t WS_V16    = WS_U16 + 128 * MiB;
constexpr size_t WS_PPROJ  = WS_V16 + 128 * MiB;
constexpr size_t WS_FILT   = WS_PPROJ + 64 * MiB;
constexpr size_t WS_H      = WS_FILT + 64 * MiB;
constexpr size_t WS_XN     = WS_H + 64 * MiB;
constexpr size_t WS_POOLIN = WS_XN + 32 * MiB;
constexpr size_t WS_HYT    = WS_POOLIN + 16 * MiB;
constexpr size_t WS_GATES  = WS_HYT + 48 * MiB;
constexpr size_t WS_PD     = WS_GATES + 64 * MiB;
constexpr size_t WS_APRE   = WS_PD + 16 * MiB;
constexpr size_t WS_Z2T    = WS_APRE + 16 * MiB;
constexpr size_t WS_Z2     = WS_Z2T + 16 * MiB;
constexpr size_t WS_AG     = WS_Z2 + 16 * MiB;
constexpr size_t WS_MIX    = WS_AG + 32 * MiB;
constexpr size_t WS_IDX    = WS_MIX + 32 * MiB;
constexpr size_t WS_GATE   = WS_IDX + 4 * MiB;
constexpr size_t WS_END    = WS_GATE + 4 * MiB;
constexpr size_t WS_Q      = WS_HYT;
constexpr size_t WS_SCORES = WS_GATES;

struct Params { const float* in[28]; float* out; unsigned char* ws; int layer, pad; };

DEV unsigned cvt_pk_bf16(float lo, float hi) { unsigned r; asm volatile("v_cvt_pk_bf16_f32 %0, %1, %2" : "=v"(r) : "v"(lo), "v"(hi)); return r; }
DEV float bf_lo(unsigned u) { return __uint_as_float(u << 16); }
DEV float bf_hi(unsigned u) { return __uint_as_float(u & 0xffff0000u); }
DEV float bf1(bf16_t u) { return __uint_as_float(((unsigned)u) << 16); }
DEV bf16_t f2bf(float f) { return (bf16_t)(cvt_pk_bf16(f, 0.f) & 0xffffu); }
DEV float wave_sum(float v) {
#pragma unroll
    for (int o = 1; o < 64; o <<= 1) v += __shfl_xor(v, o);
    return v;
}
DEV float wave_max(float v) {
#pragma unroll
    for (int o = 1; o < 64; o <<= 1) v = fmaxf(v, __shfl_xor(v, o));
    return v;
}
DEV float sigmoidf_(float x) { return 1.0f / (1.0f + __expf(-x)); }
DEV float gelu_erf(float x) { return 0.5f * x * (1.0f + erff(x * 0.70710678118654752f)); }

namespace pg8 {
constexpr int BM = 256, BK = 64, HALF = 128, HTB = HALF * BK * 2, STAGE_BYTES = 8 * HTB;
HD int lds_byte(int r, int c) { const int st = (r >> 4) * 2 + (c >> 5), rr = r & 15, cc = c & 31, ob = rr * 64 + cc * 2; return st * 1024 + (ob ^ (((ob >> 9) & 1) << 5)); }
HD void stage_rc(int b, int& R, int& C) { const int st = b / 1024, sb = b % 1024, swz = sb ^ (((sb >> 9) & 1) << 5); R = (st >> 1) * 16 + swz / 64; C = (st & 1) * 32 + (swz % 64) / 2; }
HD int perm32(int rho) { const int n = rho >> 4, i = rho & 15; return 8 * (i >> 2) + 4 * n + (i & 3); }

struct Unit { const char* a; const char* b; int kind, i0, i1, i2; };
struct Gemm { int K, lda, ldb; };

template <class Epi, class Sched>
__device__ __forceinline__ void gemm_phase(LAS unsigned char* lds, const Gemm g, const Sched& S, const Epi& E) {
    const int tid = threadIdx.x, wid = __builtin_amdgcn_readfirstlane(tid >> 6), lane = tid & 63, wr = wid >> 2, wc = wid & 3, fr = lane & 15, fq = lane >> 4;
    const int K = g.K, nt = K / BK;
    unsigned voffA[2], voffB[2];
#pragma unroll
    for (int i = 0; i < 2; ++i) { int R, C; stage_rc(tid * 16 + i * 8192, R, C); const int Rb = (R & ~31) + perm32(R & 31);
        voffA[i] = (unsigned)(R * g.lda + C) * 2u; voffB[i] = (unsigned)(Rb * g.ldb + C) * 2u; }
    const size_t kstep = (size_t)(BK * 2);
    const size_t hstepA = (size_t)HALF * g.lda * 2, hstepB = (size_t)HALF * g.ldb * 2;
    const unsigned ldsw = (unsigned)wid * 1024u;
    const int aoff = lds_byte(wr * 64 + fr, fq * 8), boff = lds_byte(wc * 32 + fr, fq * 8);
#define PG8_SA(b, h) (((b) * 2 + (h)) * HTB)
#define PG8_SB(b, h) ((4 + (b) * 2 + (h)) * HTB)
#define PG8_STAGE(bufoff, gbase, voff) do { _Pragma("unroll") for (int _i = 0; _i < 2; ++_i) \
        __builtin_amdgcn_global_load_lds((const unsigned*)((const char*)(gbase) + (voff)[_i]), (LAS unsigned*)(lds + (bufoff) + ldsw + _i * 8192), 16, 0, 0); } while (0)
#define PG8_LDA(dst, b, h) do { _Pragma("unroll") for (int m = 0; m < 4; ++m) _Pragma("unroll") for (int k = 0; k < 2; ++k) dst[m][k] = *(const LAS bf16x8*)(lds + PG8_SA(b, h) + aoff + m * 2048 + k * 1024); } while (0)
#define PG8_LDB(dst, b, h) do { _Pragma("unroll") for (int n = 0; n < 2; ++n) _Pragma("unroll") for (int k = 0; k < 2; ++k) dst[n][k] = *(const LAS bf16x8*)(lds + PG8_SB(b, h) + boff + n * 2048 + k * 1024); } while (0)
#define PG8_MMA(ai, bj, At, Bt) do { __builtin_amdgcn_s_setprio(1); _Pragma("unroll") for (int m = 0; m < 4; ++m) _Pragma("unroll") for (int n = 0; n < 2; ++n) _Pragma("unroll") for (int k = 0; k < 2; ++k) \
        acc[ai][bj][m][n] = __builtin_amdgcn_mfma_f32_16x16x32_bf16(Bt[n][k], At[m][k], acc[ai][bj][m][n], 0, 0, 0); __builtin_amdgcn_s_setprio(0); } while (0)
#define PG8_WAIT_V(n) asm volatile("s_waitcnt vmcnt(" #n ")" ::: "memory")
#define PG8_WAIT_L(n) asm volatile("s_waitcnt lgkmcnt(" #n ")" ::: "memory")
#define PG8_BAR __builtin_amdgcn_s_barrier()
#define PG8_SCHED __builtin_amdgcn_sched_barrier(0)
    Unit cur, nxt; int ui = 0;
    if (!S.next(0, cur)) return;
    f32x4 acc[2][2][4][2];
#pragma unroll
    for (int a = 0; a < 2; ++a)
#pragma unroll
        for (int b = 0; b < 2; ++b)
#pragma unroll
            for (int m = 0; m < 4; ++m)
#pragma unroll
                for (int n = 0; n < 2; ++n) acc[a][b][m][n] = (f32x4){0.f, 0.f, 0.f, 0.f};
    bf16x8 At[4][2], B0[2][2], B1[2][2];
    const char* cA = cur.a; const char* cB = cur.b;
    PG8_STAGE(PG8_SB(0, 0), cB, voffB); PG8_STAGE(PG8_SA(0, 0), cA, voffA); PG8_STAGE(PG8_SB(0, 1), cB + hstepB, voffB); PG8_STAGE(PG8_SA(0, 1), cA + hstepA, voffA);
    if (wr == 1) PG8_BAR;
    PG8_WAIT_V(4); PG8_BAR;
    PG8_STAGE(PG8_SB(1, 0), cB + kstep, voffB); PG8_STAGE(PG8_SA(1, 0), cA + kstep, voffA); PG8_STAGE(PG8_SB(1, 1), cB + hstepB + kstep, voffB);
    PG8_WAIT_V(6); PG8_BAR;
    for (;;) {
        const bool has_next = S.next(ui + 1, nxt);
        const char* nA = has_next ? nxt.a : cA; const char* nB = has_next ? nxt.b : cB;
        for (int t = 0; t < nt; t += 2) {
            const bool last = (t == nt - 2);
            const char* a1 = cA + (size_t)(t + 1) * kstep;
            const char* a2 = last ? nA : cA + (size_t)(t + 2) * kstep; const char* b2 = last ? nB : cB + (size_t)(t + 2) * kstep;
            const char* a3 = a2 + kstep; const char* b3 = b2 + kstep;
            PG8_LDB(B0, 0, 0); PG8_SCHED; PG8_LDA(At, 0, 0); PG8_STAGE(PG8_SA(1, 1), a1 + hstepA, voffA);
            PG8_WAIT_L(8); PG8_BAR; PG8_WAIT_L(0); PG8_MMA(0, 0, At, B0); PG8_BAR; PG8_SCHED;
            PG8_LDB(B1, 0, 1); PG8_STAGE(PG8_SB(0, 0), b2, voffB);
            PG8_BAR; PG8_WAIT_L(0); PG8_MMA(0, 1, At, B1); PG8_BAR;
            PG8_LDA(At, 0, 1); PG8_STAGE(PG8_SA(0, 0), a2, voffA);
            PG8_BAR; PG8_WAIT_L(0); PG8_MMA(1, 0, At, B0); PG8_BAR; PG8_SCHED;
            PG8_STAGE(PG8_SB(0, 1), b2 + hstepB, voffB);
            PG8_WAIT_V(6); PG8_BAR; PG8_MMA(1, 1, At, B1); PG8_BAR;
            PG8_LDB(B0, 1, 0); PG8_SCHED; PG8_LDA(At, 1, 0); PG8_STAGE(PG8_SA(0, 1), a2 + hstepA, voffA);
            PG8_WAIT_L(8); PG8_BAR; PG8_WAIT_L(0); PG8_MMA(0, 0, At, B0); PG8_BAR; PG8_SCHED;
            PG8_LDB(B1, 1, 1); PG8_STAGE(PG8_SB(1, 0), b3, voffB);
            PG8_BAR; PG8_WAIT_L(0); PG8_MMA(0, 1, At, B1); PG8_BAR;
            PG8_LDA(At, 1, 1); PG8_STAGE(PG8_SA(1, 0), a3, voffA);
            PG8_BAR; PG8_WAIT_L(0); PG8_MMA(1, 0, At, B0); PG8_BAR; PG8_SCHED;
            PG8_STAGE(PG8_SB(1, 1), b3 + hstepB, voffB);
            PG8_WAIT_V(6); PG8_BAR; PG8_MMA(1, 1, At, B1); PG8_BAR;
        }
        E(acc, cur, wr, wc, fr, fq);
        if (!has_next) break;
#pragma unroll
        for (int a = 0; a < 2; ++a)
#pragma unroll
            for (int b = 0; b < 2; ++b)
#pragma unroll
                for (int m = 0; m < 4; ++m)
#pragma unroll
                    for (int n = 0; n < 2; ++n) acc[a][b][m][n] = (f32x4){0.f, 0.f, 0.f, 0.f};
        cur = nxt; cA = nA; cB = nB; ++ui;
    }
    PG8_WAIT_V(0);
    if (wr == 0) PG8_BAR;
    PG8_BAR;
#undef PG8_SA
#undef PG8_SB
#undef PG8_STAGE
#undef PG8_LDA
#undef PG8_LDB
#undef PG8_MMA
#undef PG8_WAIT_V
#undef PG8_WAIT_L
#undef PG8_BAR
#undef PG8_SCHED
}

template <class F> struct Epi {
    F f;
    __device__ __forceinline__ void operator()(const f32x4 (&acc)[2][2][4][2], const Unit& u, int wr, int wc, int fr, int fq) const {
#pragma unroll
        for (int ai = 0; ai < 2; ++ai)
#pragma unroll
            for (int m = 0; m < 4; ++m) {
                const int row = ai * HALF + wr * 64 + m * 16 + fr;
#pragma unroll
                for (int bj = 0; bj < 2; ++bj) f.store(u, row, bj * HALF + wc * 32 + 8 * fq, acc[ai][bj][m][0], acc[ai][bj][m][1]);
            }
    }
};
}
using pg8::Unit;

DEV void st_bf16x8(bf16_t* p, f32x4 v0, f32x4 v1) {
    u32x4 o; o.x = cvt_pk_bf16(v0[0], v0[1]); o.y = cvt_pk_bf16(v0[2], v0[3]); o.z = cvt_pk_bf16(v1[0], v1[1]); o.w = cvt_pk_bf16(v1[2], v1[3]);
    *(u32x4*)p = o;
}
DEV void ld_bf16x8(const bf16_t* p, f32x4& v0, f32x4& v1) {
    const u32x4 q = *(const u32x4*)p;
    v0 = (f32x4){bf_lo(q.x), bf_hi(q.x), bf_lo(q.y), bf_hi(q.y)}; v1 = (f32x4){bf_lo(q.z), bf_hi(q.z), bf_lo(q.w), bf_hi(q.w)};
}
DEV f32x4 sig4(f32x4 v) { return (f32x4){sigmoidf_(v[0]), sigmoidf_(v[1]), sigmoidf_(v[2]), sigmoidf_(v[3])}; }

template <class Dec> struct FlatSched {
    Dec d; int total, G, c;
    __device__ __forceinline__ bool next(int i, Unit& u) const { const int idx = i * G + c; if (idx >= total) return false; d.decode(idx, u); return true; }
};

typedef float cf __attribute__((ext_vector_type(2)));
#define CF(a, b) ((cf){(a), (b)})
DEV cf cadd(cf a, cf b) { return a + b; }
DEV cf csub(cf a, cf b) { return a - b; }
DEV cf cmul(cf a, cf b) { return CF(a.x * b.x - a.y * b.y, a.x * b.y + a.y * b.x); }
template <bool INV> DEV cf twid(float x) { const float c = __builtin_amdgcn_cosf(x), s = __builtin_amdgcn_sinf(x); return CF(c, INV ? s : -s); }
template <int K, bool INV> DEV cf mulw16(cf a) {
    constexpr float C1 = 0.9238795325112867f, S1 = 0.3826834323650898f, C2 = 0.7071067811865476f;
    if constexpr (K == 0) return a;
    else if constexpr (K == 4) return INV ? CF(-a.y, a.x) : CF(a.y, -a.x);
    else {
        constexpr float wr = (K == 1) ? C1 : (K == 2) ? C2 : (K == 3) ? S1 : (K == 5) ? -S1 : (K == 6) ? -C2 : -C1;
        constexpr float wi0 = (K == 1) ? -S1 : (K == 2) ? -C2 : (K == 3) ? -C1 : (K == 5) ? -C1 : (K == 6) ? -C2 : -S1;
        constexpr float wi = INV ? -wi0 : wi0;
        return CF(a.x * wr - a.y * wi, a.x * wi + a.y * wr);
    }
}
template <int S, int I, bool INV> DEV void bfly(cf& a, cf& b) { const cf t = csub(a, b); a = cadd(a, b); b = mulw16<I * (8 / S), INV>(t); }
template <bool INV> DEV void dft16(cf (&x)[16]) {
    bfly<8, 0, INV>(x[0], x[8]);  bfly<8, 1, INV>(x[1], x[9]);  bfly<8, 2, INV>(x[2], x[10]); bfly<8, 3, INV>(x[3], x[11]);
    bfly<8, 4, INV>(x[4], x[12]); bfly<8, 5, INV>(x[5], x[13]); bfly<8, 6, INV>(x[6], x[14]); bfly<8, 7, INV>(x[7], x[15]);
#define BF4(o) bfly<4, 0, INV>(x[o + 0], x[o + 4]); bfly<4, 1, INV>(x[o + 1], x[o + 5]); bfly<4, 2, INV>(x[o + 2], x[o + 6]); bfly<4, 3, INV>(x[o + 3], x[o + 7]);
    BF4(0) BF4(8)
#undef BF4
#define BF2(o) bfly<2, 0, INV>(x[o + 0], x[o + 2]); bfly<2, 1, INV>(x[o + 1], x[o + 3]);
    BF2(0) BF2(4) BF2(8) BF2(12)
#undef BF2
#define BF1(o) bfly<1, 0, INV>(x[o], x[o + 1]);
    BF1(0) BF1(2) BF1(4) BF1(6) BF1(8) BF1(10) BF1(12) BF1(14)
#undef BF1
    cf t;
    t = x[1]; x[1] = x[8]; x[8] = t;   t = x[2]; x[2] = x[4]; x[4] = t;   t = x[3]; x[3] = x[12]; x[12] = t;
    t = x[5]; x[5] = x[10]; x[10] = t; t = x[7]; x[7] = x[14]; x[14] = t; t = x[11]; x[11] = x[13]; x[13] = t;
}
constexpr int FFT_BUF_ELEMS = 4352;
typedef LAS cf* lcf;
DEV void fft_s1f(cf (&x)[16], lcf buf, int r) {
    asm volatile("" : "+v"(r));
    dft16<false>(x);
    const int base = (r & 0xF0) + ((r ^ (r >> 4)) & 15);
    float fr = (float)r * (1.0f / 4096.0f); asm volatile("" : "+v"(fr));
    buf[base] = x[0];
#pragma unroll
    for (int b = 1; b < 16; ++b) buf[272 * b + base] = cmul(x[b], twid<false>(fr * (float)b));
}
DEV void fft_s2f(lcf buf, int r) {
    asm volatile("" : "+v"(r));
    const int b = r >> 4, rp = r & 15; cf x[16];
#pragma unroll
    for (int a = 0; a < 16; ++a) x[a] = buf[272 * b + 16 * a + (rp ^ a)];
    dft16<false>(x);
    float fr = (float)rp * (1.0f / 256.0f); asm volatile("" : "+v"(fr));
#pragma unroll
    for (int q = 0; q < 16; ++q) buf[272 * b + 16 * q + (rp ^ q)] = (q == 0) ? x[0] : cmul(x[q], twid<false>(fr * (float)q));
}
DEV void fft_s3f(cf (&x)[16], lcf buf, int r) {
    asm volatile("" : "+v"(r));
    const int b = r >> 4, bp = r & 15;
#pragma unroll
    for (int a = 0; a < 16; ++a) x[a] = buf[272 * b + 16 * bp + (a ^ bp)];
    dft16<false>(x);
}
DEV void fft_s3i(cf (&x)[16], lcf buf, int r) {
    asm volatile("" : "+v"(r));
    const int b = r >> 4, bp = r & 15;
    dft16<true>(x);
#pragma unroll
    for (int a = 0; a < 16; ++a) buf[272 * b + 16 * bp + (a ^ bp)] = x[a];
}
DEV void fft_s2i(lcf buf, int r) {
    asm volatile("" : "+v"(r));
    const int b = r >> 4, rp = r & 15; cf x[16];
    float fr = (float)rp * (1.0f / 256.0f); asm volatile("" : "+v"(fr));
#pragma unroll
    for (int q = 0; q < 16; ++q) { const cf v = buf[272 * b + 16 * q + (rp ^ q)]; x[q] = (q == 0) ? v : cmul(v, twid<true>(fr * (float)q)); }
    dft16<true>(x);
#pragma unroll
    for (int a = 0; a < 16; ++a) buf[272 * b + 16 * a + (rp ^ a)] = x[a];
}
DEV void fft_s1i(cf (&x)[16], lcf buf, int r) {
    asm volatile("" : "+v"(r));
    const int base = (r & 0xF0) + ((r ^ (r >> 4)) & 15);
    float fr = (float)r * (1.0f / 4096.0f); asm volatile("" : "+v"(fr));
    x[0] = buf[base];
#pragma unroll
    for (int b = 1; b < 16; ++b) x[b] = cmul(buf[272 * b + base], twid<true>(fr * (float)b));
    dft16<true>(x);
}

struct Frame {
    LAS unsigned char* lds;
    int tid, lane, wave, c, G;
    const Params& P;
    float* out; unsigned char* ws;
};
#define WSP(T, off) ((T*)(F.ws + (off)))

DEV void transpose_tile(const Frame& F, const float* src, int ldn, bf16_t* dst, int ldk, int k0, int n0) {
    LAS float* tile = (LAS float*)F.lds;
    const int row = F.tid >> 3, c8 = (F.tid & 7) * 8;
    const f32x4 a = *(const f32x4*)(src + (size_t)(k0 + row) * ldn + n0 + c8), b = *(const f32x4*)(src + (size_t)(k0 + row) * ldn + n0 + c8 + 4);
    LAS float* tp = tile + row * 65 + c8;
    tp[0] = a[0]; tp[1] = a[1]; tp[2] = a[2]; tp[3] = a[3]; tp[4] = b[0]; tp[5] = b[1]; tp[6] = b[2]; tp[7] = b[3];
    __syncthreads();
    const int n = row; const LAS float* s = tile + c8 * 65 + n;
    u32x4 o; o.x = cvt_pk_bf16(s[0], s[65]); o.y = cvt_pk_bf16(s[2 * 65], s[3 * 65]); o.z = cvt_pk_bf16(s[4 * 65], s[5 * 65]); o.w = cvt_pk_bf16(s[6 * 65], s[7 * 65]);
    *(u32x4*)(dst + (size_t)(n0 + n) * ldk + k0 + c8) = o;
    __syncthreads();
}
DEV void p0_transposes(const Frame& F) {
    constexpr int N_WIN = 32 * 128, N_PW = 64, N_WPO = 512, N_WHO = 512, N_WO = 1024, N_WQ = 1024, N_WG = 1024, N_WP = 128;
    constexpr int PER_LAYER = N_WIN + N_PW + N_WPO + N_WHO + N_WO + N_WQ + N_WG + N_WP;
    for (int it = F.c; it < 2 * PER_LAYER; it += F.G) {
        const int l = it / PER_LAYER; int r = it % PER_LAYER;
        if (r < N_WIN) { transpose_tile(F, F.P.in[3] + (size_t)l * D_ * INC_, INC_, WSP(bf16_t, WS_WIN_T) + (size_t)l * INC_ * D_, D_, (r / 128) * 64, (r % 128) * 64); continue; } r -= N_WIN;
        if (r < N_PW) { const int g = r / 16, q = r % 16; transpose_tile(F, F.P.in[4] + (size_t)(l * 4 + g) * 65536, 256, WSP(bf16_t, WS_WPOOL) + (size_t)(l * 4 + g) * 65536, 256, (q / 4) * 64, (q % 4) * 64); continue; } r -= N_PW;
        if (r < N_WPO) { transpose_tile(F, F.P.in[6] + (size_t)l * PW_ * D_, D_, WSP(bf16_t, WS_WPO_T) + (size_t)l * D_ * PW_, PW_, (r / 32) * 64, (r % 32) * 64); continue; } r -= N_WPO;
        if (r < N_WHO) { transpose_tile(F, F.P.in[16] + (size_t)l * HW_ * D_, D_, WSP(bf16_t, WS_WHO_T) + (size_t)l * D_ * HW_, HW_, (r / 32) * 64, (r % 32) * 64); continue; } r -= N_WHO;
        if (r < N_WO) { transpose_tile(F, F.P.in[17] + (size_t)l * D_ * D_, D_, WSP(bf16_t, WS_WO_T) + (size_t)l * D_ * D_, D_, (r / 32) * 64, (r % 32) * 64); continue; } r -= N_WO;
        if (r < N_WQ) { transpose_tile(F, F.P.in[19] + (size_t)l * D_ * D_, D_, WSP(bf16_t, WS_WQ_T) + (size_t)l * D_ * D_, D_, (r / 32) * 64, (r % 32) * 64); continue; } r -= N_WQ;
        if (r < N_WG) { transpose_tile(F, F.P.in[25] + (size_t)l * D_ * D_, D_, WSP(bf16_t, WS_WG_T) + (size_t)l * D_ * D_, D_, (r / 32) * 64, (r % 32) * 64); continue; } r -= N_WG;
        transpose_tile(F, F.P.in[26] + (size_t)l * PLE_ * D_, D_, WSP(bf16_t, WS_WP_T) + (size_t)l * D_ * PLE_, PLE_, (r / 32) * 64, (r % 32) * 64);
    }
}
DEV void convert_bf16(const Frame& F, const float* src, bf16_t* dst, size_t n) {
    const size_t n8 = n / 8;
    for (size_t i = (size_t)F.c * NTHREADS + F.tid; i < n8; i += (size_t)F.G * NTHREADS) {
        const f32x4 a = __builtin_nontemporal_load((const f32x4*)src + 2 * i), b = __builtin_nontemporal_load((const f32x4*)src + 2 * i + 1);
        u32x4 o; o.x = cvt_pk_bf16(a[0], a[1]); o.y = cvt_pk_bf16(a[2], a[3]); o.z = cvt_pk_bf16(b[0], b[1]); o.w = cvt_pk_bf16(b[2], b[3]);
        *((u32x4*)dst + i) = o;
    }
}
DEV void p0_small(const Frame& F) {
    for (int i = F.c * NTHREADS + F.tid; i < 2 * 65536; i += F.G * NTHREADS) {
        const int l = i >> 16, n = (i >> 8) & 255, k = i & 255; float v = 0.f;
        if (n < 128 && k < 128) v = F.P.in[20][(size_t)l * 16384 + n * 128 + k];
        else if (n >= 128 && k >= 128) v = F.P.in[21][(size_t)l * 16384 + (n - 128) * 128 + (k - 128)];
        WSP(bf16_t, WS_KBD)[i] = f2bf(v);
    }
    for (int i = F.c * NTHREADS + F.tid; i < 2 * 4096 * 64; i += F.G * NTHREADS) {
        const int l = i / (4096 * 64), r = i % (4096 * 64), j = r / 4096, col = r % 4096;
        const float w = F.P.in[13][(size_t)l * 64 * 4096 + (size_t)j * 4096 + col];
        const bf16_t hi = f2bf(w), lo = f2bf(w - bf1(hi));
        bf16_t* o = WSP(bf16_t, WS_W3A) + ((size_t)l * 4096 + col) * 256;
        o[j] = hi; o[64 + j] = hi; o[128 + j] = lo; o[192 + j] = 0;
    }
}
DEV void p0_hdn(const Frame& F) {
    LAS float* zf = (LAS float*)F.lds;
    LAS float* h1 = zf + 8 * 40;
    const int li = F.tid >> 6, j = F.tid & 63;
    for (int blk = F.c; blk < 2 * 256; blk += F.G) {
        const int l = blk >> 8, pos = (blk & 255) * 8 + li;
        const float* w1 = F.P.in[9] + (size_t)l * 33 * 64; const float* b1 = F.P.in[10] + l * 64; const float* w2 = F.P.in[11] + (size_t)l * 64 * 64;
        const float* b2 = F.P.in[12] + l * 64; const float* fq = F.P.in[14] + l * 64;
        if (j < 33) {
            float v;
            if (j == 0) v = (float)pos / (float)(L_ - 1);
            else { const int k = (j - 1) & 15; const double fb = 1e-4 + (double)k * ((15.0 - 1e-4) / 15.0); const double ang = (2.0 * 3.14159265358979323846 / (double)L_) * (double)pos * fb;
                v = (j <= 16) ? (float)cos(ang) : (float)(-sin(ang)); }
            zf[li * 40 + j] = v;
        }
        __syncthreads();
        float s = b1[j];
        for (int i = 0; i < 33; ++i) s += zf[li * 40 + i] * w1[i * 64 + j];
        h1[li * 64 + j] = sinf(fq[j] * s);
        __syncthreads();
        float s2 = b2[j];
        for (int i = 0; i < 64; ++i) s2 += h1[li * 64 + i] * w2[i * 64 + j];
        const float hv = sinf(fq[j] * s2);
        const bf16_t hi = f2bf(hv), lo = f2bf(hv - bf1(hi));
        bf16_t* o = WSP(bf16_t, WS_HB) + ((size_t)l * 2048 + pos) * 256;
        o[j] = hi; o[64 + j] = lo; o[128 + j] = hi; o[192 + j] = 0;
        __syncthreads();
    }
}

template <bool F32OUT> DEV void phase_rmsnorm(const Frame& F, const float* h, const float* g, void* outp) {
    for (int row = F.c * NWAVES + F.wave; row < T_; row += F.G * NWAVES) {
        const f32x4* hr = (const f32x4*)(h + (size_t)row * D_) + F.lane;
        f32x4 v[8]; float ss = 0.f;
#pragma unroll
        for (int j = 0; j < 8; ++j) { v[j] = hr[64 * j]; ss += v[j][0] * v[j][0] + v[j][1] * v[j][1] + v[j][2] * v[j][2] + v[j][3] * v[j][3]; }
        ss = wave_sum(ss);
        const float r = 1.0f / sqrtf(ss * (1.0f / D_) + EPS_);
        const f32x4* gr = (const f32x4*)g + F.lane;
#pragma unroll
        for (int j = 0; j < 8; ++j) {
            const f32x4 gg = gr[64 * j]; const f32x4 o = (f32x4){v[j][0] * r * gg[0], v[j][1] * r * gg[1], v[j][2] * r * gg[2], v[j][3] * r * gg[3]};
            if (F32OUT) *((f32x4*)((float*)outp + (size_t)row * D_) + F.lane + 64 * j) = o;
            else { u32x2 q; q.x = cvt_pk_bf16(o[0], o[1]); q.y = cvt_pk_bf16(o[2], o[3]); *((u32x2*)((bf16_t*)outp + (size_t)row * D_) + F.lane + 64 * j) = q; }
        }
    }
}

DEV void phase_pooldiff(const Frame& F) {
    const bf16_t* pin = WSP(bf16_t, WS_POOLIN); bf16_t* pd = WSP(bf16_t, WS_PD);
    for (int i = F.c * NTHREADS + F.tid; i < T_ * 128; i += F.G * NTHREADS) {
        const int t = i >> 7, c8 = (i & 127) * 8, grp = c8 >> 8, win = 2 << grp, l = t & (L_ - 1), t0 = t - l;
        const int lo = max(l - win / 2, 0), hi = min(l + win - win / 2 - 1, L_ - 1);
        float s[8] = {0.f, 0.f, 0.f, 0.f, 0.f, 0.f, 0.f, 0.f};
        for (int q = lo; q <= hi; ++q) { f32x4 a, b; ld_bf16x8(pin + (size_t)(t0 + q) * PW_ + c8, a, b); s[0] += a[0]; s[1] += a[1]; s[2] += a[2]; s[3] += a[3]; s[4] += b[0]; s[5] += b[1]; s[6] += b[2]; s[7] += b[3]; }
        f32x4 ua, ub; ld_bf16x8(pin + (size_t)t * PW_ + c8, ua, ub);
        const float inv = 1.0f / (float)(hi - lo + 1);
        st_bf16x8(pd + (size_t)t * PW_ + c8, (f32x4){s[0] * inv - ua[0], s[1] * inv - ua[1], s[2] * inv - ua[2], s[3] * inv - ua[3]}, (f32x4){s[4] * inv - ub[0], s[5] * inv - ub[1], s[6] * inv - ub[2], s[7] * inv - ub[3]});
    }
}

DEV void phase_z2_transpose(const Frame& F) {
    LAS bf16_t* tile = (LAS bf16_t*)F.lds;
    const bf16_t* src = WSP(bf16_t, WS_Z2T); bf16_t* dst = WSP(bf16_t, WS_Z2);
    const int row = F.tid >> 3, c8 = (F.tid & 7) * 8;
    for (int it = F.c; it < 16 * 128; it += F.G) {
        const int ch0 = (it >> 7) * 64, t0 = (it & 127) * 64;
        const u32x4 q = *(const u32x4*)(src + (size_t)(ch0 + row) * T_ + t0 + c8);
        LAS unsigned* tp = (LAS unsigned*)(tile + row * 72 + c8);
        tp[0] = q.x; tp[1] = q.y; tp[2] = q.z; tp[3] = q.w;
        __syncthreads();
        const LAS bf16_t* s = tile + c8 * 72 + row;
        u32x4 o;
        o.x = (unsigned)s[0] | ((unsigned)s[72] << 16); o.y = (unsigned)s[2 * 72] | ((unsigned)s[3 * 72] << 16);
        o.z = (unsigned)s[4 * 72] | ((unsigned)s[5 * 72] << 16); o.w = (unsigned)s[6 * 72] | ((unsigned)s[7 * 72] << 16);
        *(u32x4*)(dst + (size_t)(t0 + row) * HW_ + ch0 + c8) = o;
        __syncthreads();
    }
}

DEV void phase_hyena(const Frame& F, int layer) {
    lcf dbuf = (lcf)F.lds + (F.tid >> 8) * FFT_BUF_ELEMS;
    lcf spec0 = (lcf)F.lds + 2 * FFT_BUF_ELEMS, spec1 = spec0 + FFT_BUF_ELEMS;
    LAS float* red = (LAS float*)(F.lds + 4 * FFT_BUF_ELEMS * 8);
    LAS bf16_t* stg = (LAS bf16_t*)spec0;
    const int fl = F.tid >> 8, r = F.tid & 255, w4 = (F.tid >> 6) & 3;
    const bf16_t* hyt = WSP(bf16_t, WS_HYT);
    const float* filt = WSP(float, WS_FILT) + (size_t)layer * 4096 * 2048;
    const float* cw = F.P.in[7] + (size_t)layer * 3 * 3072; const float* cb = F.P.in[8] + (size_t)layer * 3072; const float* fbias = F.P.in[15] + (size_t)layer * 2 * HW_;
    bf16_t* z2t = WSP(bf16_t, WS_Z2T);
    for (int ch = F.c; ch < HW_; ch += F.G) {
#pragma unroll
        for (int i = 0; i < 6; ++i) { const int q = F.tid + i * NTHREADS, s = q >> 10, off = (q & 1023) * 8;
            const u32x4 v = *(const u32x4*)(hyt + (size_t)(s * HW_ + ch) * T_ + off);
            LAS unsigned* d = (LAS unsigned*)(stg + s * 8192 + off); d[0] = v.x; d[1] = v.y; d[2] = v.z; d[3] = v.w; }
        __syncthreads();
        float vv[2][8], x1v[2][8], x2v[2][8];
#pragma unroll
        for (int s = 0; s < 3; ++s) {
            const int cc = s * HW_ + ch; const float w0 = cw[cc], w1 = cw[3072 + cc], w2 = cw[2 * 3072 + cc], bb = cb[cc];
#pragma unroll
            for (int b2 = 0; b2 < 2; ++b2) { const LAS bf16_t* row = stg + s * 8192 + (2 * fl + b2) * 2048;
#pragma unroll
                for (int a = 0; a < 8; ++a) { const int t = 256 * a + r;
                    const float um = (t > 0) ? bf1(row[t - 1]) : 0.f, u0 = bf1(row[t]), up = (t < L_ - 1) ? bf1(row[t + 1]) : 0.f;
                    const float val = w0 * um + w1 * u0 + w2 * up + bb;
                    if (s == 0) vv[b2][a] = val; else if (s == 1) x1v[b2][a] = val; else x2v[b2][a] = val; }
                __builtin_amdgcn_sched_barrier(0); }
        }
        __syncthreads();
        {
            const int o = fl, rb = (256 - r) & 255;
            const float* hfp = filt + (size_t)((0 * 2 + o) * HW_ + ch) * L_; const float* hbp = filt + (size_t)((1 * 2 + o) * HW_ + ch) * L_;
            const float delta = fabsf(-3.0701134573253945f + (float)ch * ((-15.350567286626973f + 3.0701134573253945f) / 1023.0f));
            float hfv[8], hbv[8], sf = 0.f, sb = 0.f;
#pragma unroll
            for (int a = 0; a < 8; ++a) { const int l1 = 256 * a + r, l2 = 256 * a + rb;
                hfv[a] = hfp[l1] * __expf(-delta * (float)l1 * (1.0f / 2047.0f)); hbv[a] = hbp[l2] * __expf(-delta * (float)l2 * (1.0f / 2047.0f));
                sf += fabsf(hfv[a]); sb += fabsf(hbv[a]); }
            sf = wave_sum(sf); sb = wave_sum(sb);
            if (F.lane == 0) { red[(fl * 2 + 0) * 4 + w4] = sf; red[(fl * 2 + 1) * 4 + w4] = sb; }
            __syncthreads();
            const float nf = red[(fl * 2 + 0) * 4 + 0] + red[(fl * 2 + 0) * 4 + 1] + red[(fl * 2 + 0) * 4 + 2] + red[(fl * 2 + 0) * 4 + 3] + 1e-6f;
            const float nb = red[(fl * 2 + 1) * 4 + 0] + red[(fl * 2 + 1) * 4 + 1] + red[(fl * 2 + 1) * 4 + 2] + red[(fl * 2 + 1) * 4 + 3] + 1e-6f;
            const float kf = (1.0f / 4096.0f) / nf, kb = (1.0f / 4096.0f) / nb;
            cf x[16];
#pragma unroll
            for (int a = 0; a < 8; ++a) x[a] = CF(hfv[a] * kf, 0.f);
            if (r != 0) {
#pragma unroll
                for (int k = 0; k < 8; ++k) x[8 + k] = CF(hbv[7 - k] * kb, 0.f);
            } else {
                x[8] = CF(0.f, 0.f);
#pragma unroll
                for (int k = 1; k < 8; ++k) x[8 + k] = CF(hbv[8 - k] * kb, 0.f);
                x[0].x += hbv[0] * kb;
            }
            fft_s1f(x, dbuf, r);
            __syncthreads();
            fft_s2f(dbuf, r);
            __syncthreads();
            fft_s3f(x, dbuf, r);
            lcf sp = o ? spec1 : spec0; int ro = r; asm volatile("" : "+v"(ro)); const int b = ro >> 4, bp = ro & 15;
#pragma unroll
            for (int q = 0; q < 16; ++q) sp[272 * b + 16 * bp + (q ^ bp)] = x[q];
            __syncthreads();
        }
#pragma unroll 1
        for (int o = 0; o < 2; ++o) {
            const float bias = fbias[o * HW_ + ch];
            cf x[16];
#pragma unroll
            for (int a = 0; a < 8; ++a) x[a] = CF(vv[0][a], vv[1][a]);
#pragma unroll
            for (int a = 8; a < 16; ++a) x[a] = CF(0.f, 0.f);
            fft_s1f(x, dbuf, r);
            __syncthreads();
            fft_s2f(dbuf, r);
            __syncthreads();
            fft_s3f(x, dbuf, r);
            { lcf sp = spec0 + o * FFT_BUF_ELEMS; int ro = r; asm volatile("" : "+v"(ro)); const int b = ro >> 4, bp = ro & 15;
#pragma unroll
              for (int q = 0; q < 16; ++q) x[q] = cmul(x[q], sp[272 * b + 16 * bp + (q ^ bp)]); }
            fft_s3i(x, dbuf, r);
            __syncthreads();
            fft_s2i(dbuf, r);
            __syncthreads();
            fft_s1i(x, dbuf, r);
#pragma unroll
            for (int a = 0; a < 8; ++a) {
                vv[0][a] = (x[a].x + bias * vv[0][a]) * x1v[0][a]; vv[1][a] = (x[a].y + bias * vv[1][a]) * x1v[1][a];
                x1v[0][a] = x2v[0][a]; x1v[1][a] = x2v[1][a];
            }
        }
#pragma unroll
        for (int b2 = 0; b2 < 2; ++b2)
#pragma unroll
            for (int a = 0; a < 8; ++a) z2t[(size_t)ch * T_ + (2 * fl + b2) * L_ + 256 * a + r] = f2bf(vv[b2][a]);
        __syncthreads();
    }
}

DEV void phase_topk(const Frame& F) {
    const float* scores = WSP(float, WS_SCORES); int* idx = WSP(int, WS_IDX); float* gate = WSP(float, WS_GATE);
    LAS float* sv = (LAS float*)(F.lds + F.wave * 256);
    LAS int* si = (LAS int*)(F.lds + F.wave * 256 + 128);
    const int lane = F.lane;
    int ci, cj;
    { const int l = lane;
      if (l >= 42) { ci = 8 + (l - 42); cj = 0; }
      else { ci = (l >= 16) + (l >= 24) + (l >= 29) + (l >= 33) + (l >= 36) + (l >= 38) + (l >= 40);
             const int off = (ci == 0) ? 0 : (ci == 1) ? 16 : (ci == 2) ? 24 : (ci == 3) ? 29 : (ci == 4) ? 33 : (ci == 5) ? 36 : (ci == 6) ? 38 : 40; cj = l - off; }
      if (l >= 50) { ci = 0; cj = 0; } }
    for (int item = F.c * NWAVES + F.wave; item < T_ * 8; item += F.G * NWAVES) {
        const int t = item >> 3, h = item & 7;
        const float* s = scores + (size_t)t * 2048 + h * 256;
        const float a0 = s[lane], a1 = s[lane + 64], b0 = s[128 + lane], b1 = s[192 + lane];
        int ra0 = 0, ra1 = 0, rb0 = 0, rb1 = 0;
#pragma unroll
        for (int j = 0; j < 64; ++j) {
            const float xa = __int_as_float(__builtin_amdgcn_readlane(__float_as_int(a0), j)), ya = __int_as_float(__builtin_amdgcn_readlane(__float_as_int(a1), j));
            const float xb = __int_as_float(__builtin_amdgcn_readlane(__float_as_int(b0), j)), yb = __int_as_float(__builtin_amdgcn_readlane(__float_as_int(b1), j));
            ra0 += (xa > a0 || (xa == a0 && j < lane)) ? 1 : 0; ra0 += (ya > a0) ? 1 : 0;
            ra1 += (xa >= a1) ? 1 : 0;                          ra1 += (ya > a1 || (ya == a1 && j < lane)) ? 1 : 0;
            rb0 += (xb > b0 || (xb == b0 && j < lane)) ? 1 : 0; rb0 += (yb > b0) ? 1 : 0;
            rb1 += (xb >= b1) ? 1 : 0;                          rb1 += (yb > b1 || (yb == b1 && j < lane)) ? 1 : 0;
        }
        if (ra0 < 16) { sv[ra0] = a0; si[ra0] = lane; }
        if (ra1 < 16) { sv[ra1] = a1; si[ra1] = lane + 64; }
        if (rb0 < 16) { sv[16 + rb0] = b0; si[16 + rb0] = lane; }
        if (rb1 < 16) { sv[16 + rb1] = b1; si[16 + rb1] = lane + 64; }
        asm volatile("s_waitcnt lgkmcnt(0)" ::: "memory");
        const float cval = (lane < 50) ? (sv[ci] + sv[16 + cj]) : -3.0e38f;
        const int cidx = si[ci] * 128 + si[16 + cj];
        asm volatile("s_waitcnt lgkmcnt(0)" ::: "memory");
        int rk = 0;
#pragma unroll
        for (int j = 0; j < 50; ++j) { const float xc = __int_as_float(__builtin_amdgcn_readlane(__float_as_int(cval), j)); rk += (xc > cval || (xc == cval && j < lane)) ? 1 : 0; }
        const bool sel = (lane < 50) && (rk < 16);
        const float m = wave_max(cval);
        const float e = sel ? __expf(cval - m) : 0.f;
        const float ssum = wave_sum(e);
        if (sel) { idx[(size_t)t * 128 + h * 16 + rk] = cidx; gate[(size_t)t * 128 + h * 16 + rk] = e / ssum; }
    }
}

DEV void phase_peer_gather(const Frame& F, int layer) {
    const bf16_t* xn = WSP(bf16_t, WS_XN); const int* idx = WSP(int, WS_IDX); const float* gate = WSP(float, WS_GATE);
    const bf16_t* U = WSP(bf16_t, WS_U16) + (size_t)layer * NEXP_ * D_; const bf16_t* V = WSP(bf16_t, WS_V16) + (size_t)layer * NEXP_ * D_;
    float* h = WSP(float, WS_H);
    const int lane = F.lane;
    for (int t = F.c * NWAVES + F.wave; t < T_; t += F.G * NWAVES) {
        float hf[32], out[32];
#pragma unroll
        for (int i = 0; i < 4; ++i) { const u32x4 q = *((const u32x4*)(xn + (size_t)t * D_) + i * 64 + lane);
            hf[8 * i + 0] = bf_lo(q.x); hf[8 * i + 1] = bf_hi(q.x); hf[8 * i + 2] = bf_lo(q.y); hf[8 * i + 3] = bf_hi(q.y);
            hf[8 * i + 4] = bf_lo(q.z); hf[8 * i + 5] = bf_hi(q.z); hf[8 * i + 6] = bf_lo(q.w); hf[8 * i + 7] = bf_hi(q.w); }
#pragma unroll
        for (int k = 0; k < 32; ++k) out[k] = 0.f;
        const int my_i0 = idx[(size_t)t * 128 + lane], my_i1 = idx[(size_t)t * 128 + 64 + lane];
        const float my_g0 = gate[(size_t)t * 128 + lane], my_g1 = gate[(size_t)t * 128 + 64 + lane];
#pragma unroll 2
        for (int e = 0; e < 128; ++e) {
            const int ie = __builtin_amdgcn_readlane((e < 64) ? my_i0 : my_i1, e & 63);
            const float ge = __int_as_float(__builtin_amdgcn_readlane(__float_as_int((e < 64) ? my_g0 : my_g1), e & 63));
            const u32x4* ur = (const u32x4*)(U + (size_t)ie * D_) + lane; const u32x4* vr = (const u32x4*)(V + (size_t)ie * D_) + lane;
            u32x4 uq[4], vq[4];
#pragma unroll
            for (int i = 0; i < 4; ++i) { uq[i] = ur[64 * i]; vq[i] = vr[64 * i]; }
            float dot = 0.f;
#pragma unroll
            for (int i = 0; i < 4; ++i) {
                dot += hf[8 * i + 0] * bf_lo(uq[i].x) + hf[8 * i + 1] * bf_hi(uq[i].x) + hf[8 * i + 2] * bf_lo(uq[i].y) + hf[8 * i + 3] * bf_hi(uq[i].y)
                     + hf[8 * i + 4] * bf_lo(uq[i].z) + hf[8 * i + 5] * bf_hi(uq[i].z) + hf[8 * i + 6] * bf_lo(uq[i].w) + hf[8 * i + 7] * bf_hi(uq[i].w); }
            dot = wave_sum(dot);
            const float act = ge * gelu_erf(dot);
#pragma unroll
            for (int i = 0; i < 4; ++i) {
                out[8 * i + 0] += act * bf_lo(vq[i].x); out[8 * i + 1] += act * bf_hi(vq[i].x); out[8 * i + 2] += act * bf_lo(vq[i].y); out[8 * i + 3] += act * bf_hi(vq[i].y);
                out[8 * i + 4] += act * bf_lo(vq[i].z); out[8 * i + 5] += act * bf_hi(vq[i].z); out[8 * i + 6] += act * bf_lo(vq[i].w); out[8 * i + 7] += act * bf_hi(vq[i].w); }
        }
#pragma unroll
        for (int i = 0; i < 4; ++i) {
            f32x4* hp = (f32x4*)(h + (size_t)t * D_ + (size_t)(i * 64 + lane) * 8);
            f32x4 a = hp[0], b = hp[1];
            a[0] += out[8 * i + 0]; a[1] += out[8 * i + 1]; a[2] += out[8 * i + 2]; a[3] += out[8 * i + 3];
            b[0] += out[8 * i + 4]; b[1] += out[8 * i + 5]; b[2] += out[8 * i + 6]; b[3] += out[8 * i + 7];
            hp[0] = a; hp[1] = b;
        }
    }
}

enum { K_FILT = 0, K_PPROJ, K_POOLIN, K_GATES, K_HYT, K_APRE, K_AG, K_MIX, K_RES, K_Q, K_SCORES, K_PLE };

struct EpiAll {
    unsigned char* ws; const float* x_in; const float* pool_scale; int layer;
    __device__ __forceinline__ void store(const Unit& u, int row, int col, f32x4 v0, f32x4 v1) const {
        const int R = u.i0 + row, C = u.i1 + col;
        switch (u.kind) {
        case K_FILT: { float* o = (float*)(ws + WS_FILT) + ((size_t)u.i2 * 4096 + R) * 2048 + C; *(f32x4*)o = v0; *(f32x4*)(o + 4) = v1; } break;
        case K_PPROJ: st_bf16x8((bf16_t*)(ws + WS_PPROJ) + ((size_t)u.i2 * T_ + R) * D_ + C, v0, v1); break;
        case K_POOLIN: st_bf16x8((bf16_t*)(ws + WS_POOLIN) + (size_t)R * PW_ + C, v0, v1); break;
        case K_GATES: st_bf16x8((bf16_t*)(ws + WS_GATES) + (size_t)R * 4096 + C, sig4(v0), sig4(v1)); break;
        case K_HYT: st_bf16x8((bf16_t*)(ws + WS_HYT) + (size_t)R * T_ + C, v0, v1); break;
        case K_APRE: { const f32x4 s0 = *(const f32x4*)(pool_scale + C), s1 = *(const f32x4*)(pool_scale + C + 4); st_bf16x8((bf16_t*)(ws + WS_APRE) + (size_t)R * PW_ + C, v0 * s0, v1 * s1); } break;
        case K_AG: { f32x4 g0, g1; ld_bf16x8((const bf16_t*)(ws + WS_GATES) + (size_t)R * 4096 + C, g0, g1); st_bf16x8((bf16_t*)(ws + WS_AG) + (size_t)R * D_ + C, v0 * g0, v1 * g1); } break;
        case K_MIX: { f32x4 g0, g1, a0, a1; ld_bf16x8((const bf16_t*)(ws + WS_GATES) + (size_t)R * 4096 + 2048 + C, g0, g1); ld_bf16x8((const bf16_t*)(ws + WS_AG) + (size_t)R * D_ + C, a0, a1);
                      st_bf16x8((bf16_t*)(ws + WS_MIX) + (size_t)R * D_ + C, a0 + v0 * g0, a1 + v1 * g1); } break;
        case K_RES: { const float* hi = x_in + (size_t)R * D_ + C; float* ho = (float*)(ws + WS_H) + (size_t)R * D_ + C;
                      const f32x4 h0 = *(const f32x4*)hi, h1 = *(const f32x4*)(hi + 4); *(f32x4*)ho = h0 + v0; *(f32x4*)(ho + 4) = h1 + v1; } break;
        case K_Q: st_bf16x8((bf16_t*)(ws + WS_Q) + (size_t)R * D_ + C, v0, v1); break;
        case K_SCORES: { float* o = (float*)(ws + WS_SCORES) + (size_t)R * D_ + C; *(f32x4*)o = v0; *(f32x4*)(o + 4) = v1; } break;
        case K_PLE: { float* ho = (float*)(ws + WS_H) + (size_t)R * D_ + C; f32x4 p0, p1; ld_bf16x8((const bf16_t*)(ws + WS_PPROJ) + ((size_t)layer * T_ + R) * D_ + C, p0, p1);
                      const f32x4 h0 = *(const f32x4*)ho, h1 = *(const f32x4*)(ho + 4); *(f32x4*)ho = h0 + sig4(v0) * p0; *(f32x4*)(ho + 4) = h1 + sig4(v1) * p1; } break;
        }
    }
};

#define TILE_BYTES(ld) ((size_t)256 * (ld) * 2)
struct DecP0b {
    unsigned char* ws;
    __device__ __forceinline__ void decode(int idx, Unit& u) const {
        if (idx < 256) { const int l = idx >> 7, r = idx & 127, pm = r >> 3, pn = r & 7;
            u.a = (const char*)(ws + WS_W3A) + (size_t)l * 4096 * 512 + (size_t)pm * TILE_BYTES(256); u.b = (const char*)(ws + WS_HB) + (size_t)l * 2048 * 512 + (size_t)pn * TILE_BYTES(256);
            u.kind = K_FILT; u.i0 = pm * 256; u.i1 = pn * 256; u.i2 = l; }
        else { const int v = idx - 256, l = v >> 8, r = v & 255, pm = r & 31, pn = r >> 5;
            u.a = (const char*)(ws + WS_P16) + (size_t)l * T_ * 512 + (size_t)pm * TILE_BYTES(256); u.b = (const char*)(ws + WS_WP_T) + (size_t)l * D_ * 512 + (size_t)pn * TILE_BYTES(256);
            u.kind = K_PPROJ; u.i0 = pm * 256; u.i1 = pn * 256; u.i2 = l; }
    }
};
struct DecG1 {
    unsigned char* ws; int layer;
    __device__ __forceinline__ void decode(int idx, Unit& u) const {
        const char* xn = (const char*)(ws + WS_XN); const char* w = (const char*)(ws + WS_WIN_T) + (size_t)layer * INC_ * D_ * 2;
        if (idx < 640) { const int pm = idx & 31, j = idx >> 5, pnw = (j < 4) ? j : j + 12;
            u.a = xn + (size_t)pm * TILE_BYTES(D_); u.b = w + (size_t)pnw * TILE_BYTES(D_);
            if (j < 4) { u.kind = K_POOLIN; u.i0 = pm * 256; u.i1 = pnw * 256; } else { u.kind = K_GATES; u.i0 = pm * 256; u.i1 = (pnw - 16) * 256; }
            u.i2 = 0; }
        else { const int v = idx - 640, pn = v & 31, pmw = 4 + (v >> 5);
            u.a = w + (size_t)pmw * TILE_BYTES(D_); u.b = xn + (size_t)pn * TILE_BYTES(D_);
            u.kind = K_HYT; u.i0 = (pmw - 4) * 256; u.i1 = pn * 256; u.i2 = 0; }
    }
};
struct DecSimple {
    const char* A; const char* B; int lda, ldb, nM, kind, a_col_step  , b_tile_rows  ;
    __device__ __forceinline__ void decode(int idx, Unit& u) const {
        const int pm = idx % nM, pn = idx / nM;
        u.a = A + (size_t)pm * TILE_BYTES(lda) + (size_t)pn * a_col_step; u.b = B + (size_t)pn * b_tile_rows * ldb * 2;
        u.kind = kind; u.i0 = pm * 256; u.i1 = pn * 256; u.i2 = 0;
    }
};

template <class Dec> DEV void run_gemm(const Frame& F, const Dec& d, int total, int K, int lda, int ldb, const pg8::Epi<EpiAll>& E) {
    FlatSched<Dec> S{d, total, F.G, F.c};
    pg8::gemm_phase<pg8::Epi<EpiAll>, FlatSched<Dec>>(F.lds, pg8::Gemm{K, lda, ldb}, S, E);
}

template <int S> DEV void run_step(const Frame& F, int l) {
    unsigned char* ws = F.ws;
    if constexpr (S == 100) {
        p0_transposes(F);
        for (int ll = 0; ll < 2; ++ll) {
            convert_bf16(F, F.P.in[22] + (size_t)ll * NEXP_ * D_, WSP(bf16_t, WS_U16) + (size_t)ll * NEXP_ * D_, (size_t)NEXP_ * D_);
            convert_bf16(F, F.P.in[23] + (size_t)ll * NEXP_ * D_, WSP(bf16_t, WS_V16) + (size_t)ll * NEXP_ * D_, (size_t)NEXP_ * D_);
        }
        convert_bf16(F, F.P.in[1], WSP(bf16_t, WS_P16), (size_t)2 * T_ * PLE_);
        p0_small(F);
        p0_hdn(F);
        phase_rmsnorm<false>(F, F.P.in[0], F.P.in[2], WSP(bf16_t, WS_XN));
    } else if constexpr (S == 101) {
        pg8::Epi<EpiAll> E{EpiAll{ws, nullptr, nullptr, 0}}; run_gemm(F, DecP0b{ws}, 768, 256, 256, 256, E);
    } else if constexpr (S == 102) {
        phase_rmsnorm<true>(F, WSP(float, WS_H), F.P.in[27], F.out);
    } else {
        const float* hin = (l == 0) ? F.P.in[0] : WSP(float, WS_H);
        pg8::Epi<EpiAll> E{EpiAll{ws, hin, F.P.in[5] + (size_t)l * PW_, l}};
        if constexpr (S == 0) { if (l > 0) phase_rmsnorm<false>(F, WSP(float, WS_H), F.P.in[2] + (size_t)l * D_, WSP(bf16_t, WS_XN)); }
        else if constexpr (S == 1) run_gemm(F, DecG1{ws, l}, 1024, D_, D_, D_, E);
        else if constexpr (S == 2) { phase_pooldiff(F); phase_hyena(F, l); }
        else if constexpr (S == 3) { phase_z2_transpose(F);
            run_gemm(F, DecSimple{(const char*)(ws + WS_PD), (const char*)(ws + WS_WPOOL) + (size_t)l * 4 * 65536 * 2, PW_, 256, 32, K_APRE, 512, 256}, 128, 256, PW_, 256, E); }
        else if constexpr (S == 4) run_gemm(F, DecSimple{(const char*)(ws + WS_APRE), (const char*)(ws + WS_WPO_T) + (size_t)l * D_ * PW_ * 2, PW_, PW_, 32, K_AG, 0, 256}, 256, PW_, PW_, PW_, E);
        else if constexpr (S == 5) run_gemm(F, DecSimple{(const char*)(ws + WS_Z2), (const char*)(ws + WS_WHO_T) + (size_t)l * D_ * HW_ * 2, HW_, HW_, 32, K_MIX, 0, 256}, 256, HW_, HW_, HW_, E);
        else if constexpr (S == 6) run_gemm(F, DecSimple{(const char*)(ws + WS_MIX), (const char*)(ws + WS_WO_T) + (size_t)l * D_ * D_ * 2, D_, D_, 32, K_RES, 0, 256}, 256, D_, D_, D_, E);
        else if constexpr (S == 7) phase_rmsnorm<false>(F, WSP(float, WS_H), F.P.in[18] + (size_t)l * D_, WSP(bf16_t, WS_XN));
        else if constexpr (S == 8) run_gemm(F, DecSimple{(const char*)(ws + WS_XN), (const char*)(ws + WS_WQ_T) + (size_t)l * D_ * D_ * 2, D_, D_, 32, K_Q, 0, 256}, 256, D_, D_, D_, E);
        else if constexpr (S == 9) run_gemm(F, DecSimple{(const char*)(ws + WS_Q), (const char*)(ws + WS_KBD) + (size_t)l * 65536 * 2, D_, 256, 32, K_SCORES, 512, 0}, 256, 256, D_, 256, E);
        else if constexpr (S == 10) phase_topk(F);
        else if constexpr (S == 11) phase_peer_gather(F, l);
        else if constexpr (S == 12) phase_rmsnorm<false>(F, WSP(float, WS_H), F.P.in[24] + (size_t)l * D_, WSP(bf16_t, WS_XN));
        else if constexpr (S == 13) run_gemm(F, DecSimple{(const char*)(ws + WS_XN), (const char*)(ws + WS_WG_T) + (size_t)l * D_ * D_ * 2, D_, D_, 32, K_PLE, 0, 256}, 256, D_, D_, D_, E);
    }
}

template <int S> __global__ void __launch_bounds__(NTHREADS, 2) mk_step(Params p) {
    extern __shared__ __attribute__((aligned(16))) unsigned char lds_raw[];
    Frame F{(LAS unsigned char*)lds_raw, (int)threadIdx.x, (int)(threadIdx.x & 63), __builtin_amdgcn_readfirstlane((int)(threadIdx.x >> 6)), (int)blockIdx.x, (int)gridDim.x, p, p.out, p.ws};
    run_step<S>(F, p.layer);
}

template <int S> static bool launch_step(Params& p, int layer, int grid, hipStream_t stream) {
    static bool attr = false;
    if (!attr) { if (hipFuncSetAttribute((const void*)mk_step<S>, hipFuncAttributeMaxDynamicSharedMemorySize, LDS_BYTES) != hipSuccess) { fprintf(stderr, "kernel_launch: hipFuncSetAttribute failed (step %d)\n", S); return false; } attr = true; }
    p.layer = layer;
    hipLaunchKernelGGL(mk_step<S>, dim3(grid), dim3(NTHREADS), LDS_BYTES, stream, p);
    return true;
}

extern "C" void kernel_launch(void* const* d_in, const int* in_sizes, int n_in, void* d_out, int out_size, void* d_ws, size_t ws_size, hipStream_t stream) {
    static int grid = 0;
    if (grid == 0) {
        if (n_in != 28 || out_size != T_ * D_ || ws_size < WS_END) { fprintf(stderr, "kernel_launch: unexpected shapes (n_in %d, out %d, ws %zu, need %zu)\n", n_in, out_size, ws_size, (size_t)WS_END); grid = -1; return; }
        int dev = 0, cus = 0;
        (void)hipGetDevice(&dev); (void)hipDeviceGetAttribute(&cus, hipDeviceAttributeMultiprocessorCount, dev);
        grid = cus > 0 ? cus : 256;
    }
    if (grid < 0) return;
    Params p{};
    for (int i = 0; i < 28; ++i) p.in[i] = (const float*)d_in[i];
    p.out = (float*)d_out; p.ws = (unsigned char*)d_ws;
    launch_step<100>(p, 0, grid, stream);
    launch_step<101>(p, 0, grid, stream);
    for (int l = 0; l < DEPTH_; ++l) {
        if (l > 0) launch_step<0>(p, l, grid, stream);
        launch_step<1>(p, l, grid, stream); launch_step<2>(p, l, grid, stream); launch_step<3>(p, l, grid, stream); launch_step<4>(p, l, grid, stream);
        launch_step<5>(p, l, grid, stream); launch_step<6>(p, l, grid, stream); launch_step<7>(p, l, grid, stream); launch_step<8>(p, l, grid, stream);
        launch_step<9>(p, l, grid, stream); launch_step<10>(p, l, grid, stream); launch_step<11>(p, l, grid, stream); launch_step<12>(p, l, grid, stream);
        launch_step<13>(p, l, grid, stream);
    }
    launch_step<102>(p, 0, grid, stream);
}
```

```cpp
#include <hip/hip_runtime.h>
#include <cstdio>
#include <cstdint>

#ifndef MK_ONE_LAUNCH
#define MK_ONE_LAUNCH 1
#endif

#ifndef REP_P0
#define REP_P0 1
#endif
#ifndef REP_P0B
#define REP_P0B 1
#endif
#ifndef REP_NORM
#define REP_NORM 1
#endif
#ifndef REP_G1
#define REP_G1 1
#endif
#ifndef REP_HY
#define REP_HY 1
#endif
#ifndef REP_GS
#define REP_GS 1
#endif
#ifndef REP_GQ
#define REP_GQ 1
#endif
#ifndef REP_TOPK
#define REP_TOPK 1
#endif
#ifndef REP_PU
#define REP_PU 1
#endif
#ifndef REP_PV
#define REP_PV 1
#endif
#ifndef REP_PUD
#define REP_PUD 1
#endif
#ifndef REP_P0T
#define REP_P0T 1
#endif
#ifndef REP_P0C
#define REP_P0C 1
#endif
#ifndef REP_P0S
#define REP_P0S 1
#endif
#define LAS __attribute__((address_space(3)))
#define HD __host__ __device__ __forceinline__
#define DEV __device__ __forceinline__

typedef unsigned short bf16_t;
typedef short bf16x8 __attribute__((ext_vector_type(8)));
typedef float f32x4 __attribute__((ext_vector_type(4)));
typedef unsigned u32x4 __attribute__((ext_vector_type(4)));
typedef unsigned u32x2 __attribute__((ext_vector_type(2)));

constexpr int T_ = 8192, D_ = 2048, L_ = 2048, NB_ = 4, DEPTH_ = 2;
constexpr int PLE_ = 256, INC_ = 8192, HW_ = 1024, PW_ = 1024;
constexpr int NEXP_ = 16384;
constexpr float EPS_ = 1e-6f;
constexpr int NTHREADS = 512, NWAVES = 8;
constexpr int LDS_BYTES = 147456;
constexpr int SC_LD = 264;
static_assert(256 * SC_LD * 2 + 16 <= LDS_BYTES, "score tile");

constexpr size_t MiB = 1ull << 20;
constexpr size_t WS_CTL    = 0;
constexpr size_t WS_SS     = 65536;
constexpr size_t WS_SSP    = 512 * 1024;
constexpr size_t WS_WIN_T  = 1 * MiB;
constexpr size_t WS_WPOOL  = WS_WIN_T + 64 * MiB;
constexpr size_t WS_WPO_T  = WS_WPOOL + 1 * MiB;
constexpr size_t WS_WHO_T  = WS_WPO_T + 8 * MiB;
constexpr size_t WS_WO_T   = WS_WHO_T + 8 * MiB;
constexpr size_t WS_WQ_T   = WS_WO_T + 16 * MiB;
constexpr size_t WS_WG_T   = WS_WQ_T + 16 * MiB;
constexpr size_t WS_WP_T   = WS_WG_T + 16 * MiB;
constexpr size_t WS_KBD    = WS_WP_T + 2 * MiB;
constexpr size_t WS_HB     = WS_KBD + 1 * MiB;
constexpr size_t WS_W3A    = WS_HB + 2 * MiB;
constexpr size_t WS_P16    = WS_W3A + 4 * MiB;
constexpr size_t WS_U16    = WS_P16 + 8 * MiB;
constexpr size_t WS_V16    = WS_U16 + 128 * MiB;
constexpr size_t WS_PPROJ  = WS_V16 + 128 * MiB;
constexpr size_t WS_FILT   = WS_PPROJ + 64 * MiB;
constexpr size_t WS_H      = WS_FILT + 64 * MiB;
constexpr size_t WS_XN     = WS_H + 64 * MiB;
constexpr size_t WS_POOLIN = WS_XN + 32 * MiB;
constexpr size_t WS_HYT    = WS_POOLIN + 16 * MiB;
constexpr size_t WS_GATES  = WS_HYT + 48 * MiB;
constexpr size_t WS_PD     = WS_GATES + 64 * MiB;
constexpr size_t WS_APRE   = WS_PD + 16 * MiB;
constexpr size_t WS_Z2T    = WS_APRE + 16 * MiB;
constexpr size_t WS_Z2     = WS_Z2T + 16 * MiB;
constexpr size_t WS_AG     = WS_Z2 + 16 * MiB;
constexpr size_t WS_MIX    = WS_AG + 32 * MiB;
constexpr size_t WS_IDX    = WS_MIX + 32 * MiB;
constexpr size_t WS_GATE   = WS_IDX + 4 * MiB;
constexpr size_t WS_END    = WS_GATE + 4 * MiB;
constexpr size_t WS_WQK    = WS_END;
constexpr size_t WS_WCOMB  = WS_WQK + 16 * MiB;
constexpr size_t WS_END2   = WS_WCOMB + 8 * MiB;
constexpr size_t WS_HB1    = WS_H;

struct Params { const float* in[28]; float* out; unsigned char* ws; int layer, pad; };

DEV unsigned cvt_pk_bf16(float lo, float hi) { unsigned r; asm volatile("v_cvt_pk_bf16_f32 %0, %1, %2" : "=v"(r) : "v"(lo), "v"(hi)); return r; }
DEV float bf_lo(unsigned u) { return __uint_as_float(u << 16); }
DEV float bf_hi(unsigned u) { return __uint_as_float(u & 0xffff0000u); }
DEV float bf1(bf16_t u) { return __uint_as_float(((unsigned)u) << 16); }
DEV bf16_t f2bf(float f) { return (bf16_t)(cvt_pk_bf16(f, 0.f) & 0xffffu); }
template <int CTRL> DEV float dpp_f(float x) { return __builtin_bit_cast(float, __builtin_amdgcn_mov_dpp(__builtin_bit_cast(int, x), CTRL, 0xf, 0xf, true)); }
DEV float sum_xor16(float x) { const u32x2 r = __builtin_amdgcn_permlane16_swap(__float_as_uint(x), __float_as_uint(x), false, false); return __uint_as_float(r.x) + __uint_as_float(r.y); }
DEV float sum_xor32(float x) { const u32x2 r = __builtin_amdgcn_permlane32_swap(__float_as_uint(x), __float_as_uint(x), false, false); return __uint_as_float(r.x) + __uint_as_float(r.y); }
DEV float swz_xor16(float x) { return __builtin_bit_cast(float, __builtin_amdgcn_ds_swizzle(__builtin_bit_cast(int, x), 0x401F)); }
DEV float wave_sum(float v) {
    v += dpp_f<0xB1>(v); v += dpp_f<0x4E>(v); v += dpp_f<0x141>(v); v += dpp_f<0x140>(v); v += swz_xor16(v);
    return __int_as_float(__builtin_amdgcn_readlane(__float_as_int(v), 0)) + __int_as_float(__builtin_amdgcn_readlane(__float_as_int(v), 32));
}
DEV void unpk8(u32x4 q, f32x4& v0, f32x4& v1) { v0 = (f32x4){bf_lo(q.x), bf_hi(q.x), bf_lo(q.y), bf_hi(q.y)}; v1 = (f32x4){bf_lo(q.z), bf_hi(q.z), bf_lo(q.w), bf_hi(q.w)}; }
DEV float ssq8(f32x4 a, f32x4 b) { return a[0] * a[0] + a[1] * a[1] + a[2] * a[2] + a[3] * a[3] + b[0] * b[0] + b[1] * b[1] + b[2] * b[2] + b[3] * b[3]; }
typedef unsigned long long ss_t;
DEV ss_t ss_fix(float s) { return (ss_t)(s * 16777216.0f + 0.5f); }
DEV float rstd_of(ss_t ss) { return __builtin_amdgcn_rsqf((float)ss * (1.0f / 16777216.0f / D_) + EPS_); }
DEV float sigmoidf_(float x) { return __builtin_amdgcn_rcpf(1.0f + __expf(-x)); }
DEV float gelu_erf(float x) { return 0.5f * x * (1.0f + erff(x * 0.70710678118654752f)); }

#ifndef GEMM_SP2
#define GEMM_SP2 true
#endif
#ifndef GEMM_ALIGN
#define GEMM_ALIGN true
#endif
namespace pg8 {
constexpr int BM = 256, BK = 64, HALF = 128, HTB = HALF * BK * 2, STAGE_BYTES = 8 * HTB;
HD int lds_byte(int r, int c) { const int st = (r >> 4) * 2 + (c >> 5), rr = r & 15, cc = c & 31, ob = rr * 64 + cc * 2; return st * 1024 + (ob ^ (((ob >> 9) & 1) << 5)); }
HD void stage_rc(int b, int& R, int& C) { const int st = b / 1024, sb = b % 1024, swz = sb ^ (((sb >> 9) & 1) << 5); R = (st >> 1) * 16 + swz / 64; C = (st & 1) * 32 + (swz % 64) / 2; }
HD int perm32(int rho) { const int n = rho >> 4, i = rho & 15; return 8 * (i >> 2) + 4 * n + (i & 3); }

struct Unit { const char* a; const char* b; int kind, i0, i1, i2; };
struct Gemm { int K, lda, ldb; };

template <class Epi, class Sched, bool ALIGN_EPI = GEMM_ALIGN, bool SP2 = GEMM_SP2>
__device__ __forceinline__ void gemm_phase(LAS unsigned char* lds, const int tid, const Gemm g, const Sched& S, const Epi& E) {
    const int wid = __builtin_amdgcn_readfirstlane(tid >> 6), lane = tid & 63, wr = wid >> 2, wc = wid & 3, fr = lane & 15, fq = lane >> 4;
    const int K = g.K, nt = K / BK;
    unsigned voffA[2], voffB[2];
#pragma unroll
    for (int i = 0; i < 2; ++i) { int R, C; stage_rc(tid * 16 + i * 8192, R, C); const int Rb = (R & ~31) + perm32(R & 31);
        voffA[i] = (unsigned)(R * g.lda + C) * 2u; voffB[i] = (unsigned)(Rb * g.ldb + C) * 2u; }
    const size_t kstep = (size_t)(BK * 2);
    const size_t hstepA = (size_t)HALF * g.lda * 2, hstepB = (size_t)HALF * g.ldb * 2;
    const unsigned ldsw = (unsigned)wid * 1024u;
    const int aoff = lds_byte(wr * 64 + fr, fq * 8), boff = lds_byte(wc * 32 + fr, fq * 8);
#define PG8_SA(b, h) (((b) * 2 + (h)) * HTB)
#define PG8_SB(b, h) ((4 + (b) * 2 + (h)) * HTB)
#define PG8_STAGE(bufoff, gbase, voff) do { const __attribute__((address_space(1))) char* _gb = (const __attribute__((address_space(1))) char*)(gbase); asm volatile("" : "+s"(_gb));     \
        _Pragma("unroll") for (int _i = 0; _i < 2; ++_i) \
        __builtin_amdgcn_global_load_lds((const __attribute__((address_space(1))) unsigned*)(_gb + (voff)[_i]), (LAS unsigned*)(lds + (bufoff) + ldsw + _i * 8192), 16, 0, 0); } while (0)
#define PG8_LDA(dst, b, h) do { _Pragma("unroll") for (int m = 0; m < 4; ++m) _Pragma("unroll") for (int k = 0; k < 2; ++k) dst[m][k] = *(const LAS bf16x8*)(lds + PG8_SA(b, h) + aoff + m * 2048 + k * 1024); } while (0)
#define PG8_LDB(dst, b, h) do { _Pragma("unroll") for (int n = 0; n < 2; ++n) _Pragma("unroll") for (int k = 0; k < 2; ++k) dst[n][k] = *(const LAS bf16x8*)(lds + PG8_SB(b, h) + boff + n * 2048 + k * 1024); } while (0)
#define PG8_MMA(ai, bj, At, Bt) do { __builtin_amdgcn_s_setprio(1); _Pragma("unroll") for (int m = 0; m < 4; ++m) _Pragma("unroll") for (int n = 0; n < 2; ++n) _Pragma("unroll") for (int k = 0; k < 2; ++k) \
        acc[ai][bj][m][n] = __builtin_amdgcn_mfma_f32_16x16x32_bf16(Bt[n][k], At[m][k], acc[ai][bj][m][n], 0, 0, 0); __builtin_amdgcn_s_setprio(0); } while (0)
#define PG8_WAIT_V(n) asm volatile("s_waitcnt vmcnt(" #n ")" ::: "memory")
#define PG8_WAIT_L(n) asm volatile("s_waitcnt lgkmcnt(" #n ")" ::: "memory")
#define PG8_BAR __builtin_amdgcn_s_barrier()
#define PG8_SCHED __builtin_amdgcn_sched_barrier(0)
    Unit cur, nxt; int ui = 0;
    if (!S.next(0, cur)) return;
    f32x4 acc[2][2][4][2];
#pragma unroll
    for (int a = 0; a < 2; ++a)
#pragma unroll
        for (int b = 0; b < 2; ++b)
#pragma unroll
            for (int m = 0; m < 4; ++m)
#pragma unroll
                for (int n = 0; n < 2; ++n) acc[a][b][m][n] = (f32x4){0.f, 0.f, 0.f, 0.f};
    bf16x8 At[4][2], B0[2][2], B1[2][2];
    const char* cA = cur.a; const char* cB = cur.b;
    if constexpr (SP2) {
        PG8_STAGE(PG8_SB(0, 0), cB, voffB); PG8_STAGE(PG8_SB(0, 1), cB + hstepB, voffB); PG8_STAGE(PG8_SA(0, 0), cA, voffA); PG8_STAGE(PG8_SA(0, 1), cA + hstepA, voffA);
        if (wr == 1) PG8_BAR;
        PG8_WAIT_V(2); PG8_BAR;
        PG8_STAGE(PG8_SB(1, 0), cB + kstep, voffB); PG8_STAGE(PG8_SA(1, 0), cA + kstep, voffA); PG8_STAGE(PG8_SB(1, 1), cB + hstepB + kstep, voffB);
        PG8_WAIT_V(6); PG8_BAR;
    } else {
    PG8_STAGE(PG8_SB(0, 0), cB, voffB); PG8_STAGE(PG8_SA(0, 0), cA, voffA); PG8_STAGE(PG8_SB(0, 1), cB + hstepB, voffB); PG8_STAGE(PG8_SA(0, 1), cA + hstepA, voffA);
    if (wr == 1) PG8_BAR;
    PG8_WAIT_V(4); PG8_BAR;
    PG8_STAGE(PG8_SB(1, 0), cB + kstep, voffB); PG8_STAGE(PG8_SA(1, 0), cA + kstep, voffA); PG8_STAGE(PG8_SB(1, 1), cB + hstepB + kstep, voffB);
    PG8_WAIT_V(6); PG8_BAR;
    }
    for (;;) {
        const bool has_next = S.next(ui + 1, nxt);
        const char* nA = has_next ? nxt.a : cA; const char* nB = has_next ? nxt.b : cB;
        for (int t = 0; t < nt; t += 2) {
            const bool last = (t == nt - 2);
            const char* a1 = cA + (size_t)(t + 1) * kstep;
            const char* a2 = last ? nA : cA + (size_t)(t + 2) * kstep; const char* b2 = last ? nB : cB + (size_t)(t + 2) * kstep;
            const char* a3 = a2 + kstep; const char* b3 = b2 + kstep;
            if constexpr (SP2) {
            PG8_LDB(B0, 0, 0); PG8_LDB(B1, 0, 1); PG8_SCHED; PG8_LDA(At, 0, 0); PG8_STAGE(PG8_SA(1, 1), a1 + hstepA, voffA);
            PG8_WAIT_V(8); PG8_WAIT_L(0); PG8_BAR; PG8_MMA(0, 0, At, B0); PG8_MMA(0, 1, At, B1); PG8_BAR; PG8_SCHED;
            PG8_LDA(At, 0, 1); PG8_STAGE(PG8_SB(0, 0), b2, voffB); PG8_STAGE(PG8_SB(0, 1), b2 + hstepB, voffB); PG8_STAGE(PG8_SA(0, 0), a2, voffA);
            PG8_WAIT_V(8); PG8_WAIT_L(0); PG8_BAR; PG8_MMA(1, 0, At, B0); PG8_MMA(1, 1, At, B1); PG8_BAR; PG8_SCHED;
            PG8_LDB(B0, 1, 0); PG8_LDB(B1, 1, 1); PG8_SCHED; PG8_LDA(At, 1, 0); PG8_STAGE(PG8_SA(0, 1), a2 + hstepA, voffA);
            PG8_WAIT_V(8); PG8_WAIT_L(0); PG8_BAR; PG8_MMA(0, 0, At, B0); PG8_MMA(0, 1, At, B1); PG8_BAR; PG8_SCHED;
            PG8_LDA(At, 1, 1); PG8_STAGE(PG8_SB(1, 0), b3, voffB); PG8_STAGE(PG8_SB(1, 1), b3 + hstepB, voffB); PG8_STAGE(PG8_SA(1, 0), a3, voffA);
            PG8_WAIT_V(8); PG8_WAIT_L(0); PG8_BAR; PG8_MMA(1, 0, At, B0); PG8_MMA(1, 1, At, B1); PG8_BAR; PG8_SCHED;
            } else {
            PG8_LDB(B0, 0, 0); PG8_SCHED; PG8_LDA(At, 0, 0); PG8_STAGE(PG8_SA(1, 1), a1 + hstepA, voffA);
            PG8_WAIT_L(8); PG8_BAR; PG8_WAIT_L(0); PG8_MMA(0, 0, At, B0); PG8_BAR; PG8_SCHED;
            PG8_LDB(B1, 0, 1); PG8_STAGE(PG8_SB(0, 0), b2, voffB);
            PG8_BAR; PG8_WAIT_L(0); PG8_MMA(0, 1, At, B1); PG8_BAR;
            PG8_LDA(At, 0, 1); PG8_STAGE(PG8_SA(0, 0), a2, voffA);
            PG8_BAR; PG8_WAIT_L(0); PG8_MMA(1, 0, At, B0); PG8_BAR; PG8_SCHED;
            PG8_STAGE(PG8_SB(0, 1), b2 + hstepB, voffB);
            PG8_WAIT_V(6); PG8_BAR; PG8_MMA(1, 1, At, B1); PG8_BAR;
            PG8_LDB(B0, 1, 0); PG8_SCHED; PG8_LDA(At, 1, 0); PG8_STAGE(PG8_SA(0, 1), a2 + hstepA, voffA);
            PG8_WAIT_L(8); PG8_BAR; PG8_WAIT_L(0); PG8_MMA(0, 0, At, B0); PG8_BAR; PG8_SCHED;
            PG8_LDB(B1, 1, 1); PG8_STAGE(PG8_SB(1, 0), b3, voffB);
            PG8_BAR; PG8_WAIT_L(0); PG8_MMA(0, 1, At, B1); PG8_BAR;
            PG8_LDA(At, 1, 1); PG8_STAGE(PG8_SA(1, 0), a3, voffA);
            PG8_BAR; PG8_WAIT_L(0); PG8_MMA(1, 0, At, B0); PG8_BAR; PG8_SCHED;
            PG8_STAGE(PG8_SB(1, 1), b3 + hstepB, voffB);
            PG8_WAIT_V(6); PG8_BAR; PG8_MMA(1, 1, At, B1); PG8_BAR;
            }
        }
        if constexpr (ALIGN_EPI) { if (wr == 0) PG8_BAR; }
        E(acc, cur, wr, wc, fr, fq);
        if (!has_next) break;
#pragma unroll
        for (int a = 0; a < 2; ++a)
#pragma unroll
            for (int b = 0; b < 2; ++b)
#pragma unroll
                for (int m = 0; m < 4; ++m)
#pragma unroll
                    for (int n = 0; n < 2; ++n) acc[a][b][m][n] = (f32x4){0.f, 0.f, 0.f, 0.f};
        cur = nxt; cA = nA; cB = nB; ++ui;
        if constexpr (ALIGN_EPI) { if (wr == 1) PG8_BAR; }
    }
    PG8_WAIT_V(0);
    if constexpr (!ALIGN_EPI) { if (wr == 0) PG8_BAR; }
    PG8_BAR;
#undef PG8_SA
#undef PG8_SB
#undef PG8_STAGE
#undef PG8_LDA
#undef PG8_LDB
#undef PG8_MMA
#undef PG8_WAIT_V
#undef PG8_WAIT_L
#undef PG8_BAR
#undef PG8_SCHED
}

struct EpiCtx { float rs[8]; float cs[16]; };
struct EpiPre { u32x4 a, b, c; };
template <class F> struct Epi {
    F f;
    __device__ __forceinline__ void operator()(const f32x4 (&acc)[2][2][4][2], const Unit& u, int wr, int wc, int, int) const {
        __builtin_amdgcn_sched_barrier(0);
        int ln; asm volatile("v_mbcnt_lo_u32_b32 %0, -1, 0\n\tv_mbcnt_hi_u32_b32 %0, -1, %0" : "=v"(ln));
        const int fr = ln & 15, fq = ln >> 4;
        EpiCtx ctx; f.unit_begin(u, wr, wc, fr, fq, ctx);
        constexpr int GR = F::GROUP_ROWS;
        float ssqs[8];
#pragma unroll
        for (int ai = 0; ai < 2; ++ai)
#pragma unroll
            for (int mg = 0; mg < 4 / GR; ++mg) {
                __builtin_amdgcn_sched_barrier(0);
                EpiPre pre[GR][2];
#pragma unroll
                for (int mm = 0; mm < GR; ++mm)
#pragma unroll
                    for (int bj = 0; bj < 2; ++bj) f.pre(u, ai * HALF + wr * 64 + (GR * mg + mm) * 16 + fr, bj * HALF + wc * 32 + 8 * fq, pre[mm][bj]);
#pragma unroll
                for (int mm = 0; mm < GR; ++mm) {
                    const int m = GR * mg + mm, row = ai * HALF + wr * 64 + m * 16 + fr;
                    float ssq = 0.f;
#pragma unroll
                    for (int bj = 0; bj < 2; ++bj) ssq += f.store(u, row, bj * HALF + wc * 32 + 8 * fq, acc[ai][bj][m][0], acc[ai][bj][m][1], pre[mm][bj], ctx, ai * 4 + m, bj);
                    ssqs[ai * 4 + m] = ssq;
                }
            }
        __builtin_amdgcn_sched_barrier(0);
#pragma unroll
        for (int k = 0; k < 8; ++k) f.row_done(u, (k >> 2) * HALF + wr * 64 + (k & 3) * 16 + fr, ssqs[k], fq * 16 + fr);
    }
};
}
using pg8::Unit;

DEV void st_bf16x8(bf16_t* p, f32x4 v0, f32x4 v1) {
    u32x4 o; o.x = cvt_pk_bf16(v0[0], v0[1]); o.y = cvt_pk_bf16(v0[2], v0[3]); o.z = cvt_pk_bf16(v1[0], v1[1]); o.w = cvt_pk_bf16(v1[2], v1[3]);
    *(u32x4*)p = o;
}
DEV void st_bf16x8g(__attribute__((address_space(1))) bf16_t* p, f32x4 v0, f32x4 v1) {
    u32x4 o; o.x = cvt_pk_bf16(v0[0], v0[1]); o.y = cvt_pk_bf16(v0[2], v0[3]); o.z = cvt_pk_bf16(v1[0], v1[1]); o.w = cvt_pk_bf16(v1[2], v1[3]);
    *(__attribute__((address_space(1))) u32x4*)p = o;
}
DEV void ld_bf16x8(const bf16_t* p, f32x4& v0, f32x4& v1) {
    const u32x4 q = *(const u32x4*)p;
    v0 = (f32x4){bf_lo(q.x), bf_hi(q.x), bf_lo(q.y), bf_hi(q.y)}; v1 = (f32x4){bf_lo(q.z), bf_hi(q.z), bf_lo(q.w), bf_hi(q.w)};
}
DEV f32x4 sig4(f32x4 v) { return (f32x4){sigmoidf_(v[0]), sigmoidf_(v[1]), sigmoidf_(v[2]), sigmoidf_(v[3])}; }

template <class Dec> struct FlatSched {
    Dec d; int total, G, c;
    __device__ __forceinline__ bool next(int i, Unit& u) const { const int idx = i * G + c; if (idx < 0 || idx >= total) return false; d.decode(idx, u); return true; }
};

typedef float cf __attribute__((ext_vector_type(2)));
#define CF(a, b) ((cf){(a), (b)})
DEV cf cadd(cf a, cf b) { return a + b; }
DEV cf csub(cf a, cf b) { return a - b; }
DEV cf cmul(cf a, cf b) { return CF(a.x * b.x - a.y * b.y, a.x * b.y + a.y * b.x); }
template <bool INV> DEV cf twid(float x) { const float c = __builtin_amdgcn_cosf(x), s = __builtin_amdgcn_sinf(x); return CF(c, INV ? s : -s); }
template <bool INV> DEV void twid15(float x, cf (&w)[16]) {
    w[1] = twid<INV>(x); w[2] = cmul(w[1], w[1]); w[4] = cmul(w[2], w[2]); w[8] = cmul(w[4], w[4]);
    w[3] = cmul(w[1], w[2]); w[5] = cmul(w[1], w[4]); w[6] = cmul(w[2], w[4]); w[9] = cmul(w[1], w[8]); w[10] = cmul(w[2], w[8]); w[12] = cmul(w[4], w[8]);
    w[7] = cmul(w[3], w[4]); w[11] = cmul(w[3], w[8]); w[13] = cmul(w[5], w[8]); w[14] = cmul(w[6], w[8]); w[15] = cmul(w[7], w[8]);
}
template <int K, bool INV> DEV cf mulw16(cf a) {
    constexpr float C1 = 0.9238795325112867f, S1 = 0.3826834323650898f, C2 = 0.7071067811865476f;
    if constexpr (K == 0) return a;
    else if constexpr (K == 4) return INV ? CF(-a.y, a.x) : CF(a.y, -a.x);
    else {
        constexpr float wr = (K == 1) ? C1 : (K == 2) ? C2 : (K == 3) ? S1 : (K == 5) ? -S1 : (K == 6) ? -C2 : -C1;
        constexpr float wi0 = (K == 1) ? -S1 : (K == 2) ? -C2 : (K == 3) ? -C1 : (K == 5) ? -C1 : (K == 6) ? -C2 : -S1;
        constexpr float wi = INV ? -wi0 : wi0;
        cf r, t; const cf c = CF(wr, wi);
        asm("v_pk_mul_f32 %1, %2, %3 op_sel_hi:[1,0]\n\ts_nop 0\n\tv_pk_fma_f32 %0, %2, %3, %1 op_sel:[1,1,0] op_sel_hi:[0,1,1] neg_lo:[1,0,0]\n\ts_nop 0"
            : "=&v"(r), "=&v"(t) : "v"(a), "s"(c));
        return r;
    }
}
template <int S, int I, bool INV> DEV void bfly(cf& a, cf& b) { const cf t = csub(a, b); a = cadd(a, b); b = mulw16<I * (8 / S), INV>(t); }
template <bool INV> DEV void dft16(cf (&x)[16]) {
    bfly<8, 0, INV>(x[0], x[8]);  bfly<8, 1, INV>(x[1], x[9]);  bfly<8, 2, INV>(x[2], x[10]); bfly<8, 3, INV>(x[3], x[11]);
    bfly<8, 4, INV>(x[4], x[12]); bfly<8, 5, INV>(x[5], x[13]); bfly<8, 6, INV>(x[6], x[14]); bfly<8, 7, INV>(x[7], x[15]);
#define BF4(o) bfly<4, 0, INV>(x[o + 0], x[o + 4]); bfly<4, 1, INV>(x[o + 1], x[o + 5]); bfly<4, 2, INV>(x[o + 2], x[o + 6]); bfly<4, 3, INV>(x[o + 3], x[o + 7]);
    BF4(0) BF4(8)
#undef BF4
#define BF2(o) bfly<2, 0, INV>(x[o + 0], x[o + 2]); bfly<2, 1, INV>(x[o + 1], x[o + 3]);
    BF2(0) BF2(4) BF2(8) BF2(12)
#undef BF2
#define BF1(o) bfly<1, 0, INV>(x[o], x[o + 1]);
    BF1(0) BF1(2) BF1(4) BF1(6) BF1(8) BF1(10) BF1(12) BF1(14)
#undef BF1
    cf t;
    t = x[1]; x[1] = x[8]; x[8] = t;   t = x[2]; x[2] = x[4]; x[4] = t;   t = x[3]; x[3] = x[12]; x[12] = t;
    t = x[5]; x[5] = x[10]; x[10] = t; t = x[7]; x[7] = x[14]; x[14] = t; t = x[11]; x[11] = x[13]; x[13] = t;
}
constexpr int FFT_BUF_ELEMS = 4352;
typedef LAS cf* lcf;
DEV void fft_s1f(cf (&x)[16], lcf buf, int r) {
    asm volatile("" : "+v"(r));
    dft16<false>(x);
    const int base = 17 * (r >> 4) + (r & 15);
    float fr = (float)r * (1.0f / 4096.0f); asm volatile("" : "+v"(fr));
    buf[base] = x[0];
    cf w[16]; twid15<false>(fr, w);
#pragma unroll
    for (int b = 1; b < 16; ++b) buf[272 * b + base] = cmul(x[b], w[b]);
}
DEV void fft_s2f(lcf buf, int r) {
    asm volatile("" : "+v"(r));
    const int b = r >> 4, rp = r & 15; cf x[16];
#pragma unroll
    for (int a = 0; a < 16; ++a) x[a] = buf[272 * b + 17 * a + rp];
    dft16<false>(x);
    float fr = (float)rp * (1.0f / 256.0f); asm volatile("" : "+v"(fr));
    cf w[16]; twid15<false>(fr, w);
#pragma unroll
    for (int q = 0; q < 16; ++q) buf[272 * b + 17 * q + rp] = (q == 0) ? x[0] : cmul(x[q], w[q]);
}
DEV void fft_s3f(cf (&x)[16], lcf buf, int r) {
    asm volatile("" : "+v"(r));
    const int b = r >> 4, bp = r & 15;
#pragma unroll
    for (int a = 0; a < 16; ++a) x[a] = buf[272 * b + 17 * bp + a];
    dft16<false>(x);
}
DEV void fft_s3i(cf (&x)[16], lcf buf, int r) {
    asm volatile("" : "+v"(r));
    const int b = r >> 4, bp = r & 15;
    dft16<true>(x);
#pragma unroll
    for (int a = 0; a < 16; ++a) buf[272 * b + 17 * bp + a] = x[a];
}
DEV void fft_s2i(lcf buf, int r) {
    asm volatile("" : "+v"(r));
    const int b = r >> 4, rp = r & 15; cf x[16];
    float fr = (float)rp * (1.0f / 256.0f); asm volatile("" : "+v"(fr));
    cf w[16]; twid15<true>(fr, w);
#pragma unroll
    for (int q = 0; q < 16; ++q) { const cf v = buf[272 * b + 17 * q + rp]; x[q] = (q == 0) ? v : cmul(v, w[q]); }
    dft16<true>(x);
#pragma unroll
    for (int a = 0; a < 16; ++a) buf[272 * b + 17 * a + rp] = x[a];
}
DEV void fft_s1i(cf (&x)[16], lcf buf, int r) {
    asm volatile("" : "+v"(r));
    const int base = 17 * (r >> 4) + (r & 15);
    float fr = (float)r * (1.0f / 4096.0f); asm volatile("" : "+v"(fr));
    x[0] = buf[base];
    cf w[16]; twid15<true>(fr, w);
#pragma unroll
    for (int b = 1; b < 16; ++b) x[b] = cmul(buf[272 * b + base], w[b]);
    dft16<true>(x);
}

#define XB_TMO      128
#define XB_XCNT(j)  (256  + 64 * (j))
#define XB_XSUB(j)  (1280 + 64 * (j))
#define XB_XGEN(j)  (2304 + 64 * (j))
#define XB_TOP      3328
#define XB_TOPGEN   3392
#define XCD_BAR_WORDS 3456
#define XB_SPIN_CAP (1u << 22)
DEV unsigned xb_ld(unsigned* p)              { return __hip_atomic_load(p, __ATOMIC_RELAXED, __HIP_MEMORY_SCOPE_AGENT); }
DEV unsigned xb_add(unsigned* p, unsigned v) { return __hip_atomic_fetch_add(p, v, __ATOMIC_RELAXED, __HIP_MEMORY_SCOPE_AGENT); }
DEV unsigned xb_xcc_id() { return (unsigned)__builtin_amdgcn_s_getreg((3 << 11) | 20) & 0xFu; }
#define XB_SPIN(cond, bar) do { unsigned _sp = 0; while (cond) { __builtin_amdgcn_s_sleep(1); \
    if ((++_sp & 255u) == 0u) { if (xb_ld(&(bar)[XB_TMO])) break; if (_sp > XB_SPIN_CAP) { atomicAdd(&(bar)[XB_TMO], 1u); break; } } } } while (0)
struct XcdBarrier { unsigned* bar; unsigned x; volatile LAS unsigned* st; };
DEV XcdBarrier xcd_barrier_post(unsigned* bar, volatile LAS unsigned* st) {
    XcdBarrier b; b.bar = bar; b.x = (unsigned)__builtin_amdgcn_readfirstlane((int)xb_xcc_id()); b.st = st;
    if (threadIdx.x == 0) (void)xb_add(&bar[XB_XCNT(b.x)], 1u);
    return b;
}
DEV void xcd_barrier_complete(unsigned* bar, unsigned x, unsigned& nloc, unsigned& nx) {
    const unsigned G = gridDim.x * gridDim.y * gridDim.z;
    unsigned sum, cnt, mine, sp = 0u;
    for (;;) {
        sum = 0u; cnt = 0u; mine = 0u;
#pragma unroll 1
        for (unsigned j = 0; j < 16; ++j) { const unsigned c = xb_ld(&bar[XB_XCNT(j)]); sum += c; cnt += (c > 0u) ? 1u : 0u; mine = (j == x) ? c : mine; }
        if (sum == G) break;
        __builtin_amdgcn_s_sleep(1);
        if ((++sp & 255u) == 0u) { if (xb_ld(&bar[XB_TMO])) break; if (sp > XB_SPIN_CAP) { atomicAdd(&bar[XB_TMO], 1u); break; } }
    }
    nloc = mine > 0u ? mine : 1u; nx = cnt > 0u ? cnt : 1u;
}
DEV void xcd_barrier(const XcdBarrier& b) {
    asm volatile("s_waitcnt vmcnt(0)" ::: "memory");
    __syncthreads();
    if (threadIdx.x == 0) {
        unsigned* bar = b.bar;
        const unsigned bx = (unsigned)__builtin_amdgcn_readfirstlane((int)xb_xcc_id());
        __builtin_amdgcn_s_waitcnt(0);
        unsigned nloc = b.st[0], nx = b.st[1];
        if (nloc == 0u) { xcd_barrier_complete(bar, bx, nloc, nx); b.st[0] = nloc; b.st[1] = nx; }
        const unsigned old = xb_add(&bar[XB_XSUB(bx)], 1u);
        const unsigned gen = old / nloc;
        if (old + 1u == (gen + 1u) * nloc) {
            __builtin_amdgcn_fence(__ATOMIC_RELEASE, "agent");
            asm volatile("s_waitcnt vmcnt(0)" ::: "memory");
            const unsigned og = xb_add(&bar[XB_TOP], 1u);
            const unsigned tg = og / nx;
            if (og + 1u == (tg + 1u) * nx) xb_add(&bar[XB_TOPGEN], 1u);
            else XB_SPIN(xb_ld(&bar[XB_TOPGEN]) == tg, bar);
            __builtin_amdgcn_fence(__ATOMIC_ACQUIRE, "agent");
            xb_add(&bar[XB_XGEN(bx)], 1u);
            asm volatile("s_waitcnt vmcnt(0)" ::: "memory");
        } else {
            XB_SPIN(xb_ld(&bar[XB_XGEN(bx)]) == gen, bar);
            __builtin_amdgcn_fence(__ATOMIC_ACQUIRE, "agent");
            asm volatile("s_waitcnt vmcnt(0)" ::: "memory");
        }
    }
    __syncthreads();
}

struct Frame {
    LAS unsigned char* lds;
    int tid, lane, wave, c, G;
    const __attribute__((address_space(4))) Params* P;
    float* out; unsigned char* ws;
};
#define WSP(T, off) ((T*)(F.ws + (off)))

DEV void transpose_item(const Frame& F, const float* src, int ldn, bf16_t* dst, int ldk, int k0, int n0, const float* kscale = nullptr) {
    LAS float* tile = (LAS float*)F.lds;
    const int row = F.tid >> 3, c8 = (F.tid & 7) * 8;
    const float ks = kscale ? kscale[k0 + row] : 1.0f;
    f32x4 a[4], b[4];
#pragma unroll
    for (int q = 0; q < 4; ++q) { const float* sp = src + (size_t)(k0 + row) * ldn + n0 + 64 * q + c8; a[q] = (*((const f32x4*)sp)); b[q] = (*((const f32x4*)(sp + 4))); }
#pragma unroll
    for (int q = 0; q < 4; ++q) { LAS float* tp = tile + q * (64 * 65) + row * 65 + c8; const f32x4 x = a[q] * ks, y = b[q] * ks;
        tp[0] = x[0]; tp[1] = x[1]; tp[2] = x[2]; tp[3] = x[3]; tp[4] = y[0]; tp[5] = y[1]; tp[6] = y[2]; tp[7] = y[3]; }
    __syncthreads();
#pragma unroll
    for (int q = 0; q < 4; ++q) { const int n = row; const LAS float* sq = tile + q * (64 * 65) + c8 * 65 + n;
        u32x4 o; o.x = cvt_pk_bf16(sq[0], sq[65]); o.y = cvt_pk_bf16(sq[2 * 65], sq[3 * 65]); o.z = cvt_pk_bf16(sq[4 * 65], sq[5 * 65]); o.w = cvt_pk_bf16(sq[6 * 65], sq[7 * 65]);
        *(u32x4*)(dst + (size_t)(n0 + 64 * q + n) * ldk + k0 + c8) = o; }
    __syncthreads();
}
DEV void p0_transposes(const Frame& F) {
    constexpr int N_WIN = 32 * 32, N_WPO = 128, N_WHO = 128, N_WO = 256, N_WG = 256, N_WP = 32;
    constexpr int PER_LAYER = N_WIN + N_WPO + N_WHO + N_WO + N_WG + N_WP;
    for (int it = F.c; it < 2 * PER_LAYER; it += F.G) {
        const int l = it / PER_LAYER; int r = it % PER_LAYER;
        if (r < N_WIN) { transpose_item(F, F.P->in[3] + (size_t)l * D_ * INC_, INC_, WSP(bf16_t, WS_WIN_T) + (size_t)l * INC_ * D_, D_, (r / 32) * 64, (r % 32) * 256, F.P->in[2] + (size_t)l * D_); continue; } r -= N_WIN;
        if (r < N_WPO) { transpose_item(F, F.P->in[6] + (size_t)l * PW_ * D_, D_, WSP(bf16_t, WS_WPO_T) + (size_t)l * D_ * PW_, PW_, (r / 8) * 64, (r % 8) * 256, F.P->in[5] + (size_t)l * PW_); continue; } r -= N_WPO;
        if (r < N_WHO) { transpose_item(F, F.P->in[16] + (size_t)l * HW_ * D_, D_, WSP(bf16_t, WS_WHO_T) + (size_t)l * D_ * HW_, HW_, (r / 8) * 64, (r % 8) * 256); continue; } r -= N_WHO;
        if (r < N_WO) { transpose_item(F, F.P->in[17] + (size_t)l * D_ * D_, D_, WSP(bf16_t, WS_WO_T) + (size_t)l * D_ * D_, D_, (r / 8) * 64, (r % 8) * 256); continue; } r -= N_WO;
        if (r < N_WG) { transpose_item(F, F.P->in[25] + (size_t)l * D_ * D_, D_, WSP(bf16_t, WS_WG_T) + (size_t)l * D_ * D_, D_, (r / 8) * 64, (r % 8) * 256, F.P->in[24] + (size_t)l * D_); continue; } r -= N_WG;
        transpose_item(F, F.P->in[26] + (size_t)l * PLE_ * D_, D_, WSP(bf16_t, WS_WP_T) + (size_t)l * D_ * PLE_, PLE_, (r / 8) * 64, (r % 8) * 256);
    }
}
DEV void convert_bf16(const Frame& F, const float* src, bf16_t* dst, size_t n) {
    const size_t n8 = n / 8, stride = (size_t)F.G * NTHREADS;
    for (size_t i0 = (size_t)F.c * NTHREADS + F.tid; i0 < n8; i0 += 4 * stride) {
        f32x4 a[4], b[4];
#pragma unroll
        for (int u = 0; u < 4; ++u) { const size_t i = i0 + u * stride; if (i < n8) { a[u] = (*((const f32x4*)src + 2 * i)); b[u] = (*((const f32x4*)src + 2 * i + 1)); } }
#pragma unroll
        for (int u = 0; u < 4; ++u) { const size_t i = i0 + u * stride; if (i < n8) {
            u32x4 o; o.x = cvt_pk_bf16(a[u][0], a[u][1]); o.y = cvt_pk_bf16(a[u][2], a[u][3]); o.z = cvt_pk_bf16(b[u][0], b[u][1]); o.w = cvt_pk_bf16(b[u][2], b[u][3]);
            *((u32x4*)dst + i) = o; } }
    }
}
typedef float f32x2 __attribute__((ext_vector_type(2)));
constexpr float PEER_U_SCALE = 256.0f, PEER_V_SCALE = 16.0f;
constexpr size_t PEER_SLS = (size_t)NEXP_ * 128 + 33 * 256;
constexpr size_t PEER_TBL = 48 * MiB;
DEV unsigned pk4_fp8(f32x4 a, float sc) { int w = __builtin_amdgcn_cvt_pk_fp8_f32(a[0] * sc, a[1] * sc, 0, false); w = __builtin_amdgcn_cvt_pk_fp8_f32(a[2] * sc, a[3] * sc, w, true); return (unsigned)w; }
DEV void convert_sliced(const Frame& F, const float* src, unsigned char* dst, float sc, const float* dscale) {
    const size_t n16 = (size_t)NEXP_ * D_ / 16, stride = (size_t)F.G * NTHREADS;
    for (size_t i0 = (size_t)F.c * NTHREADS + F.tid; i0 < n16; i0 += 2 * stride) {
        f32x4 v[2][4];
#pragma unroll
        for (int u = 0; u < 2; ++u) { const f32x4* sp = (const f32x4*)src + 4 * (i0 + u * stride);
#pragma unroll
            for (int q = 0; q < 4; ++q) v[u][q] = sp[q]; }
#pragma unroll
        for (int u = 0; u < 2; ++u) { const size_t i = i0 + u * stride;
            if (dscale) { const f32x4* gp = (const f32x4*)dscale + 4 * (i & 127);
#pragma unroll
                for (int q = 0; q < 4; ++q) v[u][q] *= gp[q]; }
            u32x4 o; o.x = pk4_fp8(v[u][0], sc); o.y = pk4_fp8(v[u][1], sc); o.z = pk4_fp8(v[u][2], sc); o.w = pk4_fp8(v[u][3], sc);
            const size_t e = i >> 7, cc = i & 127, sl = cc >> 3, j8 = cc & 7;
            *(u32x4*)(dst + (sl * PEER_SLS + e * 128 + j8 * 16)) = o; }
    }
}
DEV void convert_rows(const Frame& F, const float* src, bf16_t* dst, int R, int C, const float* rowscale) {
    const int c8n = C / 8, total = R * c8n, stride = F.G * NTHREADS;
    for (int i0 = F.c * NTHREADS + F.tid; i0 < total; i0 += 4 * stride) {
        f32x4 a[4], b[4]; float rs[4];
#pragma unroll
        for (int u = 0; u < 4; ++u) { const int i = i0 + u * stride; if (i < total) { rs[u] = rowscale ? rowscale[i / c8n] : 1.0f; a[u] = (*((const f32x4*)src + 2 * (size_t)i)); b[u] = (*((const f32x4*)src + 2 * (size_t)i + 1)); } }
#pragma unroll
        for (int u = 0; u < 4; ++u) { const int i = i0 + u * stride; if (i < total) { const f32x4 x = a[u] * rs[u], y = b[u] * rs[u];
            u32x4 o; o.x = cvt_pk_bf16(x[0], x[1]); o.y = cvt_pk_bf16(x[2], x[3]); o.z = cvt_pk_bf16(y[0], y[1]); o.w = cvt_pk_bf16(y[2], y[3]);
            *((u32x4*)dst + i) = o; } }
    }
}
DEV void p0_small(const Frame& F) {
    for (int i = F.c * NTHREADS + F.tid; i < 2 * 65536; i += F.G * NTHREADS) {
        const int l = i >> 16, n = (i >> 8) & 255, k = i & 255; float v = 0.f;
        if (n < 128 && k < 128) v = F.P->in[20][(size_t)l * 16384 + n * 128 + k];
        else if (n >= 128 && k >= 128) v = F.P->in[21][(size_t)l * 16384 + (n - 128) * 128 + (k - 128)];
        WSP(bf16_t, WS_KBD)[i] = f2bf(v);
    }
    for (int i = F.c * NTHREADS + F.tid; i < 2 * 4096 * 64; i += F.G * NTHREADS) {
        const int l = i / (4096 * 64), r = i % (4096 * 64), j = r / 4096, col = r % 4096;
        const float w = F.P->in[13][(size_t)l * 64 * 4096 + (size_t)j * 4096 + col];
        const bf16_t hi = f2bf(w), lo = f2bf(w - bf1(hi));
        bf16_t* o = WSP(bf16_t, WS_W3A) + ((size_t)l * 4096 + col) * 256;
        o[j] = hi; o[64 + j] = hi; o[128 + j] = lo; o[192 + j] = 0;
    }
}
DEV void p0_hdn(const Frame& F) {
    LAS float* zf = (LAS float*)F.lds;
    LAS float* h1 = zf + 8 * 40;
    const int li = F.tid >> 6, j = F.tid & 63;
    for (int blk = F.c; blk < 2 * 256; blk += F.G) {
        const int l = blk >> 8, pos = (blk & 255) * 8 + li;
        const float* w1 = F.P->in[9] + (size_t)l * 33 * 64; const float* b1 = F.P->in[10] + l * 64; const float* w2 = F.P->in[11] + (size_t)l * 64 * 64;
        const float* b2 = F.P->in[12] + l * 64; const float* fq = F.P->in[14] + l * 64;
        if (j < 33) {
            float v;
            if (j == 0) v = (float)pos / (float)(L_ - 1);
            else { const int k = (j - 1) & 15; const double fb = 1e-4 + (double)k * ((15.0 - 1e-4) / 15.0); const double ang = (2.0 * 3.14159265358979323846 / (double)L_) * (double)pos * fb;
                v = (j <= 16) ? (float)cos(ang) : (float)(-sin(ang)); }
            zf[li * 40 + j] = v;
        }
        __syncthreads();
        float s = b1[j];
        for (int i = 0; i < 33; ++i) s += zf[li * 40 + i] * w1[i * 64 + j];
        h1[li * 64 + j] = sinf(fq[j] * s);
        __syncthreads();
        float s2 = b2[j];
        for (int i = 0; i < 64; ++i) s2 += h1[li * 64 + i] * w2[i * 64 + j];
        const float hv = sinf(fq[j] * s2);
        const bf16_t hi = f2bf(hv), lo = f2bf(hv - bf1(hi));
        bf16_t* o = WSP(bf16_t, WS_HB) + ((size_t)l * 2048 + pos) * 256;
        o[j] = hi; o[64 + j] = lo; o[128 + j] = hi; o[192 + j] = 0;
        __syncthreads();
    }
}

DEV void phase_final_norm(const Frame& F, const bf16_t* h, const float* g, float* outp) {
    for (int row = F.c * NWAVES + F.wave; row < T_; row += F.G * NWAVES) {
        const u32x4* hr = (const u32x4*)(h + (size_t)row * D_) + F.lane;
        f32x4 v[8]; float ss = 0.f;
#pragma unroll
        for (int j = 0; j < 4; ++j) { const u32x4 q = hr[64 * j]; v[2 * j] = (f32x4){bf_lo(q.x), bf_hi(q.x), bf_lo(q.y), bf_hi(q.y)}; v[2 * j + 1] = (f32x4){bf_lo(q.z), bf_hi(q.z), bf_lo(q.w), bf_hi(q.w)};
            ss += ssq8(v[2 * j], v[2 * j + 1]); }
        ss = wave_sum(ss);
        const float r = 1.0f / sqrtf(ss * (1.0f / D_) + EPS_);
#pragma unroll
        for (int j = 0; j < 4; ++j) { const f32x4* gr = (const f32x4*)(g + 512 * j + 8 * F.lane); float* op = outp + (size_t)row * D_ + 512 * j + 8 * F.lane;
            *(f32x4*)op = v[2 * j] * r * gr[0]; *(f32x4*)(op + 4) = v[2 * j + 1] * r * gr[1]; }
    }
}
template <bool F32OUT> DEV void phase_rmsnorm(const Frame& F, const float* h, const float* g, void* outp) {
    for (int row = F.c * NWAVES + F.wave; row < T_; row += F.G * NWAVES) {
        const f32x4* hr = (const f32x4*)(h + (size_t)row * D_) + F.lane;
        f32x4 v[8]; float ss = 0.f;
#pragma unroll
        for (int j = 0; j < 8; ++j) { v[j] = hr[64 * j]; ss += v[j][0] * v[j][0] + v[j][1] * v[j][1] + v[j][2] * v[j][2] + v[j][3] * v[j][3]; }
        ss = wave_sum(ss);
        const float r = 1.0f / sqrtf(ss * (1.0f / D_) + EPS_);
        const f32x4* gr = (const f32x4*)g + F.lane;
#pragma unroll
        for (int j = 0; j < 8; ++j) {
            const f32x4 gg = gr[64 * j]; const f32x4 o = (f32x4){v[j][0] * r * gg[0], v[j][1] * r * gg[1], v[j][2] * r * gg[2], v[j][3] * r * gg[3]};
            if (F32OUT) *((f32x4*)((float*)outp + (size_t)row * D_) + F.lane + 64 * j) = o;
            else { u32x2 q; q.x = cvt_pk_bf16(o[0], o[1]); q.y = cvt_pk_bf16(o[2], o[3]); *((u32x2*)((bf16_t*)outp + (size_t)row * D_) + F.lane + 64 * j) = q; }
        }
    }
}

DEV void phase_rowstat(const Frame& F, const float* h, bf16_t* hb, ss_t* ss) {
    for (int i = F.c * NTHREADS + F.tid; i < 6 * T_; i += F.G * NTHREADS) ss[T_ + i] = 0ull;
    const int rstep = F.G * NWAVES;
    for (int row = F.c * NWAVES + F.wave; row < T_; row += 2 * rstep) {
        f32x4 v[2][8];
#pragma unroll
        for (int k = 0; k < 2; ++k) { const f32x4* hr = (const f32x4*)(h + (size_t)(row + k * rstep) * D_) + F.lane;
#pragma unroll
            for (int j = 0; j < 8; ++j) v[k][j] = hr[64 * j]; }
#pragma unroll
        for (int k = 0; k < 2; ++k) { const int rk = row + k * rstep; float s2 = 0.f;
#pragma unroll
            for (int j = 0; j < 8; ++j) { const f32x4 x = v[k][j]; s2 += x[0] * x[0] + x[1] * x[1] + x[2] * x[2] + x[3] * x[3];
                u32x2 q; q.x = cvt_pk_bf16(x[0], x[1]); q.y = cvt_pk_bf16(x[2], x[3]); *((u32x2*)(hb + (size_t)rk * D_) + F.lane + 64 * j) = q; }
            s2 = wave_sum(s2);
            if (F.lane == 0) ss[rk] = ss_fix(s2); }
    }
}

DEV void pooldiff_item(const bf16_t* pin, int i, f32x4& o0, f32x4& o1) {
    const int t = i >> 7, c8 = (i & 127) * 8, grp = c8 >> 8, win = 2 << grp, l = t & (L_ - 1), t0 = t - l;
    const int lo = max(l - win / 2, 0), hi = min(l + win - win / 2 - 1, L_ - 1);
    float s[8] = {0.f, 0.f, 0.f, 0.f, 0.f, 0.f, 0.f, 0.f};
    for (int q = lo; q <= hi; ++q) { f32x4 a, b; ld_bf16x8(pin + (size_t)(t0 + q) * PW_ + c8, a, b); s[0] += a[0]; s[1] += a[1]; s[2] += a[2]; s[3] += a[3]; s[4] += b[0]; s[5] += b[1]; s[6] += b[2]; s[7] += b[3]; }
    f32x4 ua, ub; ld_bf16x8(pin + (size_t)t * PW_ + c8, ua, ub);
    const float inv = 1.0f / (float)(hi - lo + 1);
    o0 = (f32x4){s[0] * inv - ua[0], s[1] * inv - ua[1], s[2] * inv - ua[2], s[3] * inv - ua[3]}; o1 = (f32x4){s[4] * inv - ub[0], s[5] * inv - ub[1], s[6] * inv - ub[2], s[7] * inv - ub[3]};
}
DEV void phase_pooldiff(const Frame& F) {
    const bf16_t* pin = WSP(bf16_t, WS_POOLIN); bf16_t* pd = WSP(bf16_t, WS_PD);
    const int stride = F.G * NTHREADS;
    for (int i = F.c * NTHREADS + F.tid; i < T_ * 128; i += 2 * stride) {
        f32x4 a0, a1, b0, b1; pooldiff_item(pin, i, a0, a1); pooldiff_item(pin, i + stride, b0, b1);
        st_bf16x8(pd + (size_t)(i >> 7) * PW_ + (i & 127) * 8, a0, a1); st_bf16x8(pd + (size_t)((i + stride) >> 7) * PW_ + ((i + stride) & 127) * 8, b0, b1);
    }
}

DEV void phase_z2_transpose(const Frame& F) {
    LAS bf16_t* tile = (LAS bf16_t*)F.lds;
    const bf16_t* src = WSP(bf16_t, WS_Z2T); bf16_t* dst = WSP(bf16_t, WS_Z2);
    const int row = F.tid >> 3, c8 = (F.tid & 7) * 8;
    for (int it = F.c; it < 16 * 32; it += F.G) {
        const int ch0 = (it >> 5) * 64, t0 = (it & 31) * 256;
        u32x4 q[4];
#pragma unroll
        for (int k = 0; k < 4; ++k) q[k] = *(const u32x4*)(src + (size_t)(ch0 + row) * T_ + t0 + 64 * k + c8);
#pragma unroll
        for (int k = 0; k < 4; ++k) { LAS unsigned* tp = (LAS unsigned*)(tile + k * (64 * 72) + row * 72 + c8); tp[0] = q[k].x; tp[1] = q[k].y; tp[2] = q[k].z; tp[3] = q[k].w; }
        __syncthreads();
#pragma unroll
        for (int k = 0; k < 4; ++k) { const LAS bf16_t* sq = tile + k * (64 * 72) + c8 * 72 + row;
            u32x4 o;
            o.x = (unsigned)sq[0] | ((unsigned)sq[72] << 16); o.y = (unsigned)sq[2 * 72] | ((unsigned)sq[3 * 72] << 16);
            o.z = (unsigned)sq[4 * 72] | ((unsigned)sq[5 * 72] << 16); o.w = (unsigned)sq[6 * 72] | ((unsigned)sq[7 * 72] << 16);
            *(u32x4*)(dst + (size_t)(t0 + 64 * k + row) * HW_ + ch0 + c8) = o; }
        __syncthreads();
    }
}

#define GAS_ __attribute__((address_space(1)))
struct SideSt { const GAS_ char* isrc; GAS_ unsigned char* idst; GAS_ unsigned char* dcur; f32x4 g0, g1, pa, pb; };
DEV const GAS_ char* side_src(const Frame& F, int layer, int ch) {
    return (const GAS_ char*)(F.P->in[22 + (ch >> 9)] + (size_t)layer * NEXP_ * D_) + (size_t)(ch & 511) * 262144 + (size_t)(((F.wave >> 2) * 2048 + (F.wave & 3) * 512) * 4);
}
DEV void side_item(const Frame& F, int layer, int ch, SideSt& S) {
    S.isrc = side_src(F, layer, ch);
    S.idst = (GAS_ unsigned char*)(F.ws + ((ch >> 9) ? WS_V16 : WS_U16) + (size_t)layer * PEER_TBL + (size_t)(4 * (F.wave & 3)) * PEER_SLS + (size_t)(((ch & 511) * 32 + (F.wave >> 2)) * 128));
}
DEV void side_load(const Frame& F, SideSt& S, const GAS_ char* gb, int ln) {
    asm volatile("" : "+s"(gb));
    S.pa = *(const GAS_ f32x4*)(gb + (unsigned)ln * 32u); S.pb = *(const GAS_ f32x4*)(gb + ((unsigned)ln * 32u + 16u));
}
DEV void side_store(const Frame& F, const SideSt& S, int ln) {
    const f32x4 a = S.pa * S.g0, b = S.pb * S.g1;
    u32x2 o; o.x = pk4_fp8(a, 1.0f); o.y = pk4_fp8(b, 1.0f);
    GAS_ unsigned char* db = S.dcur; asm volatile("" : "+s"(db));
    *(GAS_ u32x2*)(db + ((unsigned)(ln >> 4) * (unsigned)PEER_SLS + 8u * (unsigned)(ln & 15))) = o;
}
DEV void side_step(const Frame& F, SideSt& S, int j) {
    int ln = F.lane; asm volatile("" : "+v"(ln));
    __builtin_amdgcn_sched_barrier(0);
    asm volatile("" : "+v"(S.pa), "+v"(S.pb));
    side_store(F, S, ln);
    side_load(F, S, S.isrc + (size_t)j * 16384, ln);
    S.dcur = S.idst + (size_t)j * 256;
    __builtin_amdgcn_sched_barrier(0);
}
#define SIDE_STEP(j) side_step(F, sst, (j))
#define HSYNC() do { asm volatile("s_waitcnt lgkmcnt(0)" ::: "memory"); __builtin_amdgcn_s_barrier(); asm volatile("" ::: "memory"); } while (0)
#define WSYNC() asm volatile("" ::: "memory")
DEV void phase_hyena(const Frame& F, int layer) {
    lcf dbuf = (lcf)F.lds + (F.tid >> 8) * FFT_BUF_ELEMS;
    lcf spec0 = (lcf)F.lds + 2 * FFT_BUF_ELEMS, spec1 = spec0 + FFT_BUF_ELEMS;
    LAS float* red = (LAS float*)(F.lds + 4 * FFT_BUF_ELEMS * 8);
    LAS bf16_t* stg = (LAS bf16_t*)spec0;
    const int fl = F.tid >> 8, r = F.tid & 255, w4 = (F.tid >> 6) & 3;
    const bf16_t* hyt = WSP(bf16_t, WS_HYT);
    const _Float16* filt = WSP(_Float16, WS_FILT) + (size_t)layer * 4096 * 2048;
    const float* cw = F.P->in[7] + (size_t)layer * 3 * 3072; const float* cb = F.P->in[8] + (size_t)layer * 3072; const float* fbias = F.P->in[15] + (size_t)layer * 2 * HW_;
    bf16_t* z2t = WSP(bf16_t, WS_Z2T);
    SideSt sst; side_item(F, layer, F.c, sst);
    { int ln = F.lane; asm volatile("" : "+v"(ln)); side_load(F, sst, sst.isrc, ln); sst.dcur = sst.idst; }
    const float* sgp = F.P->in[18] + (size_t)layer * D_ + (F.wave & 3) * 512 + 8 * F.lane;
    if ((F.c >> 9) == 0) { sst.g0 = *(const f32x4*)sgp * PEER_U_SCALE; sst.g1 = *(const f32x4*)(sgp + 4) * PEER_U_SCALE; } else { sst.g0 = PEER_V_SCALE; sst.g1 = PEER_V_SCALE; }
    for (int ch = F.c; ch < HW_; ch += F.G) {
        float hfraw[8], hbraw[8];
        { const int o = fl, rb = (256 - r) & 255;
          const _Float16* hfp = filt + (size_t)((0 * 2 + o) * HW_ + ch) * L_; const _Float16* hbp = filt + (size_t)((1 * 2 + o) * HW_ + ch) * L_;
#pragma unroll
          for (int a = 0; a < 8; ++a) { hfraw[a] = (float)hfp[256 * a + r]; hbraw[a] = (float)hbp[256 * a + rb]; } }
        float cwv[3][4];
#pragma unroll
        for (int s = 0; s < 3; ++s) { const int cc = s * HW_ + ch; cwv[s][0] = cw[cc]; cwv[s][1] = cw[3072 + cc]; cwv[s][2] = cw[2 * 3072 + cc]; cwv[s][3] = cb[cc]; }
        float fb0 = fbias[ch], fb1 = fbias[HW_ + ch];
        side_item(F, layer, ch, sst);
        f32x4 tg0, tg1; if ((ch >> 9) == 0) { tg0 = *(const f32x4*)sgp * PEER_U_SCALE; tg1 = *(const f32x4*)(sgp + 4) * PEER_U_SCALE; } else { tg0 = PEER_V_SCALE; tg1 = PEER_V_SCALE; }
#pragma unroll
        for (int i = 0; i < 6; ++i) { const int q = F.tid + i * NTHREADS, s = q >> 10, off = (q & 1023) * 8;
            const u32x4 v = *(const u32x4*)(hyt + (size_t)(s * HW_ + ch) * T_ + off);
            LAS unsigned* d = (LAS unsigned*)(stg + s * 8192 + off); d[0] = v.x; d[1] = v.y; d[2] = v.z; d[3] = v.w; }
#pragma unroll
        for (int a = 0; a < 8; ++a) { asm volatile("" : "+v"(hfraw[a])); asm volatile("" : "+v"(hbraw[a])); }
        asm volatile("" : "+v"(fb0)); asm volatile("" : "+v"(fb1));
        asm volatile("" : "+v"(tg0)); asm volatile("" : "+v"(tg1));
#pragma unroll
        for (int s = 0; s < 3; ++s) { asm volatile("" : "+v"(cwv[s][0])); asm volatile("" : "+v"(cwv[s][1])); asm volatile("" : "+v"(cwv[s][2])); asm volatile("" : "+v"(cwv[s][3])); }
        SIDE_STEP(0);
        sst.g0 = tg0; sst.g1 = tg1;
        HSYNC();
        float vv[2][8], x1v[2][8], x2v[2][8];
#pragma unroll
        for (int s = 0; s < 3; ++s) {
            const float w0 = cwv[s][0], w1 = cwv[s][1], w2 = cwv[s][2], bb = cwv[s][3];
#pragma unroll
            for (int b2 = 0; b2 < 2; ++b2) { const LAS bf16_t* row = stg + s * 8192 + (2 * fl + b2) * 2048;
#pragma unroll
                for (int a = 0; a < 8; ++a) { const int t = 256 * a + r;
                    const float um = (t > 0) ? bf1(row[t - 1]) : 0.f, u0 = bf1(row[t]), up = (t < L_ - 1) ? bf1(row[t + 1]) : 0.f;
                    const float val = w0 * um + w1 * u0 + w2 * up + bb;
                    if (s == 0) vv[b2][a] = val; else if (s == 1) x1v[b2][a] = val; else x2v[b2][a] = val; }
                __builtin_amdgcn_sched_barrier(0); }
            if (s >= 1) SIDE_STEP(s);
        }
        HSYNC();
        {
            const int o = fl, rb = (256 - r) & 255;
            const float delta = fabsf(-3.0701134573253945f + (float)ch * ((-15.350567286626973f + 3.0701134573253945f) / 1023.0f));
            float hfv[8], hbv[8], sf = 0.f, sb = 0.f;
#pragma unroll
            for (int a = 0; a < 8; ++a) { const int l1 = 256 * a + r, l2 = 256 * a + rb;
                hfv[a] = hfraw[a] * __expf(-delta * (float)l1 * (1.0f / 2047.0f)); hbv[a] = hbraw[a] * __expf(-delta * (float)l2 * (1.0f / 2047.0f));
                sf += fabsf(hfv[a]); sb += fabsf(hbv[a]); }
            sf = wave_sum(sf); sb = wave_sum(sb);
            if (F.lane == 0) { red[(fl * 2 + 0) * 4 + w4] = sf; red[(fl * 2 + 1) * 4 + w4] = sb; }
            HSYNC();
            const float nf = red[(fl * 2 + 0) * 4 + 0] + red[(fl * 2 + 0) * 4 + 1] + red[(fl * 2 + 0) * 4 + 2] + red[(fl * 2 + 0) * 4 + 3] + 1e-6f;
            const float nb = red[(fl * 2 + 1) * 4 + 0] + red[(fl * 2 + 1) * 4 + 1] + red[(fl * 2 + 1) * 4 + 2] + red[(fl * 2 + 1) * 4 + 3] + 1e-6f;
            const float kf = (1.0f / 4096.0f) / nf, kb = (1.0f / 4096.0f) / nb;
            cf x[16];
#pragma unroll
            for (int a = 0; a < 8; ++a) x[a] = CF(hfv[a] * kf, 0.f);
            if (r != 0) {
#pragma unroll
                for (int k = 0; k < 8; ++k) x[8 + k] = CF(hbv[7 - k] * kb, 0.f);
            } else {
                x[8] = CF(0.f, 0.f);
#pragma unroll
                for (int k = 1; k < 8; ++k) x[8 + k] = CF(hbv[8 - k] * kb, 0.f);
                x[0].x += hbv[0] * kb;
            }
            fft_s1f(x, dbuf, r);
            SIDE_STEP(3);
            HSYNC();
            fft_s2f(dbuf, r);
            SIDE_STEP(4);
            WSYNC();
            fft_s3f(x, dbuf, r);
            lcf sp = o ? spec1 : spec0; int ro = r; asm volatile("" : "+v"(ro)); const int b = ro >> 4, bp = ro & 15;
#pragma unroll
            for (int q = 0; q < 16; ++q) sp[272 * b + 17 * bp + q] = x[q];
            SIDE_STEP(5);
            HSYNC();
        }
#pragma unroll 1
        for (int o = 0; o < 2; ++o) {
            const float bias = o ? fb1 : fb0;
            cf x[16];
#pragma unroll
            for (int a = 0; a < 8; ++a) x[a] = CF(vv[0][a], vv[1][a]);
#pragma unroll
            for (int a = 8; a < 16; ++a) x[a] = CF(0.f, 0.f);
            fft_s1f(x, dbuf, r);
            SIDE_STEP(6 + 5 * o);
            HSYNC();
            fft_s2f(dbuf, r);
            SIDE_STEP(7 + 5 * o);
            WSYNC();
            fft_s3f(x, dbuf, r);
            { lcf sp = spec0 + o * FFT_BUF_ELEMS; int ro = r; asm volatile("" : "+v"(ro)); const int b = ro >> 4, bp = ro & 15;
#pragma unroll
              for (int q = 0; q < 16; ++q) x[q] = cmul(x[q], sp[272 * b + 17 * bp + q]); }
            fft_s3i(x, dbuf, r);
            SIDE_STEP(8 + 5 * o);
            WSYNC();
            fft_s2i(dbuf, r);
            SIDE_STEP(9 + 5 * o);
            HSYNC();
            fft_s1i(x, dbuf, r);
#pragma unroll
            for (int a = 0; a < 8; ++a) {
                vv[0][a] = (x[a].x + bias * vv[0][a]) * x1v[0][a]; vv[1][a] = (x[a].y + bias * vv[1][a]) * x1v[1][a];
                x1v[0][a] = x2v[0][a]; x1v[1][a] = x2v[1][a];
            }
            SIDE_STEP(10 + 5 * o);
        }
#pragma unroll
        for (int b2 = 0; b2 < 2; ++b2)
#pragma unroll
            for (int a = 0; a < 8; ++a) z2t[(size_t)ch * T_ + (2 * fl + b2) * L_ + 256 * a + r] = f2bf(vv[b2][a]);
        HSYNC();
    }
    { int ln = F.lane; asm volatile("" : "+v"(ln)); side_store(F, sst, ln); }
}

DEV unsigned ord_key(float f, int k) { unsigned u = __float_as_uint(f); u ^= (u >> 31) ? 0xFFFFFFFFu : 0x80000000u; return (u & ~127u) | (unsigned)(127 - k); }
DEV float key_val(unsigned key) { unsigned u = key & ~127u; u = (u & 0x80000000u) ? (u ^ 0x80000000u) : ~u; return __uint_as_float(u); }
#define INS_U32(L, x) do { _Pragma("unroll") for (int _i = 0; _i < 16; ++_i) { const unsigned _hi = max(L[_i], x); x = min(L[_i], x); L[_i] = _hi; } } while (0)
template <bool DESC> DEV void sort16(unsigned (&K)[16]) {
#define CE(a, b) do { const unsigned _lo = min(K[a], K[b]), _hi = max(K[a], K[b]); K[a] = DESC ? _hi : _lo; K[b] = DESC ? _lo : _hi; } while (0)
    CE(0, 13); CE(1, 12); CE(2, 15); CE(3, 14); CE(4, 8); CE(5, 6); CE(7, 11); CE(9, 10);
    CE(0, 5); CE(1, 7); CE(2, 9); CE(3, 4); CE(6, 13); CE(8, 14); CE(10, 15); CE(11, 12);
    CE(0, 1); CE(2, 3); CE(4, 5); CE(6, 8); CE(7, 9); CE(10, 11); CE(12, 13); CE(14, 15);
    CE(0, 2); CE(1, 3); CE(4, 10); CE(5, 11); CE(6, 7); CE(8, 9); CE(12, 14); CE(13, 15);
    CE(1, 2); CE(3, 12); CE(4, 6); CE(5, 7); CE(8, 10); CE(9, 11); CE(13, 14);
    CE(1, 4); CE(2, 6); CE(5, 8); CE(7, 10); CE(9, 13); CE(11, 14);
    CE(2, 4); CE(3, 6); CE(9, 12); CE(11, 13);
    CE(3, 5); CE(6, 8); CE(7, 9); CE(10, 12);
    CE(3, 4); CE(5, 6); CE(7, 8); CE(9, 10); CE(11, 12);
    CE(6, 7); CE(8, 9);
#undef CE
}
DEV void merge_top16(unsigned (&L)[16], const unsigned (&K)[16]) {
#pragma unroll
    for (int i = 0; i < 16; ++i) L[i] = max(L[i], K[i]);
#pragma unroll
    for (int s = 8; s >= 1; s >>= 1)
#pragma unroll
        for (int i = 0; i < 16; ++i)
            if ((i & s) == 0) { const unsigned lo = min(L[i], L[i + s]), hi = max(L[i], L[i + s]); L[i] = hi; L[i + s] = lo; }
}
DEV unsigned cand_key(float f, int c) { unsigned u = __float_as_uint(f); u ^= (u >> 31) ? 0xFFFFFFFFu : 0x80000000u; return (u & ~255u) | (unsigned)(255 - c); }
DEV float cand_val(unsigned key) { unsigned u = key & ~255u; u = (u & 0x80000000u) ? (u ^ 0x80000000u) : ~u; return __uint_as_float(u); }
DEV void phase_topk(const Frame& F) {
    int* idx = WSP(int, WS_IDX); float* gate = WSP(float, WS_GATE);
    const int lane = F.lane, w4 = F.wave & 3, half = F.wave >> 2;
    LAS unsigned char* kown = F.lds + (half * 128) * (SC_LD * 2) + w4 * 128;
    LAS unsigned char* kpart = F.lds + 128 * (SC_LD * 2) + w4 * 128;
#define KEYAT(base, i, l) (*(LAS unsigned*)((base) + (2 * (i) + ((l) >> 5)) * (SC_LD * 2) + ((l) & 31) * 4))
    __syncthreads();
    {
        const int h = F.c >> 5, t = (F.c & 31) * 256 + w4 * 64 + lane;
        unsigned L1[16];
        {
            const LAS _Float16* sp = (const LAS _Float16*)F.lds + (half * 128) * SC_LD + w4 * 64 + lane;
            float cur[16], nxt[16];
#pragma unroll
            for (int i = 0; i < 16; ++i) cur[i] = (float)sp[i * SC_LD];
#pragma unroll
            for (int blk = 0; blk < 8; ++blk) {
                if (blk < 7) {
#pragma unroll
                    for (int i = 0; i < 16; ++i) nxt[i] = (float)sp[(16 * (blk + 1) + i) * SC_LD];
                }
                unsigned K[16];
#pragma unroll
                for (int i = 0; i < 16; ++i) K[i] = ord_key(cur[i], 16 * blk + i);
                if (blk == 0) {
                    sort16<true>(K);
#pragma unroll
                    for (int i = 0; i < 16; ++i) L1[i] = K[i];
                } else { sort16<false>(K); merge_top16(L1, K); }
#pragma unroll
                for (int i = 0; i < 16; ++i) cur[i] = nxt[i];
                __builtin_amdgcn_sched_barrier(0);
            }
#pragma unroll
            for (int i = 0; i < 16; ++i) KEYAT(kown, i, lane) = L1[i];
        }
        __syncthreads();
        if (half == 0) {
            float v1[16], v2[16];
#pragma unroll
            for (int i = 0; i < 16; ++i) { v1[i] = key_val(L1[i]); v2[i] = key_val(KEYAT(kpart, i, lane)); }
#define CK(I, J) cand_key(v1[I] + v2[J], 16 * (I) + (J))
            unsigned C[16];
#pragma unroll
            for (int j = 0; j < 16; ++j) C[j] = cand_key(v1[0] + v2[j], j);
            { unsigned K[16] = {CK(1, 0), CK(1, 1), CK(1, 2), CK(1, 3), CK(1, 4), CK(1, 5), CK(1, 6), CK(1, 7), CK(2, 0), CK(2, 1), CK(2, 2), CK(2, 3), CK(2, 4), CK(3, 0), CK(3, 1), CK(3, 2)};
              sort16<false>(K); merge_top16(C, K); }
            { unsigned K[16] = {CK(3, 3), CK(4, 0), CK(4, 1), CK(4, 2), CK(5, 0), CK(5, 1), CK(6, 0), CK(6, 1), CK(7, 0), CK(7, 1), CK(8, 0), CK(9, 0), CK(10, 0), CK(11, 0), CK(12, 0), CK(13, 0)};
              sort16<false>(K); merge_top16(C, K); }
            { unsigned x = CK(14, 0); INS_U32(C, x); unsigned y = CK(15, 0); INS_U32(C, y); }
#undef CK
            float e[16], ssum = 0.f; int cp[16];
            const float c0 = cand_val(C[0]);
#pragma unroll
            for (int i = 0; i < 16; ++i) {
                e[i] = __expf(cand_val(C[i]) - c0); ssum += e[i];
                const unsigned c = 255u - (C[i] & 255u);
                const unsigned k1 = KEYAT(kown, c >> 4, lane), k2 = KEYAT(kpart, c & 15u, lane);
                cp[i] = (127 - (int)(k1 & 127u)) * 128 + (127 - (int)(k2 & 127u));
            }
            const float inv = 1.0f / ssum;
            int* ip = idx + (size_t)t * 128 + h * 16; float* gp = gate + (size_t)t * 128 + h * 16;
#pragma unroll
            for (int q = 0; q < 4; ++q) {
                *(int4*)(ip + 4 * q) = make_int4(cp[4 * q], cp[4 * q + 1], cp[4 * q + 2], cp[4 * q + 3]);
                *(f32x4*)(gp + 4 * q) = (f32x4){e[4 * q] * inv, e[4 * q + 1] * inv, e[4 * q + 2] * inv, e[4 * q + 3] * inv};
            }
        }
        __syncthreads();
    }
#undef KEYAT
}

#define GAS __attribute__((address_space(1)))
template <class T> DEV GAS T* sptr(T* p) { GAS T* q = (GAS T*)p; asm volatile("" : "+s"(q)); return q; }
template <class T> DEV T gld(const GAS void* base, unsigned byteoff) { asm volatile("" : "+v"(byteoff)); return *(const GAS T*)((const GAS char*)base + byteoff); }
template <class T> DEV void gst(GAS void* base, unsigned byteoff, T v) { asm volatile("" : "+v"(byteoff)); *(GAS T*)((GAS char*)base + byteoff) = v; }
template <int CTRL> DEV float dppf(float x) { return __builtin_bit_cast(float, __builtin_amdgcn_mov_dpp(__builtin_bit_cast(int, x), CTRL, 0xf, 0xf, true)); }
constexpr int DPP_XOR1 = 0xB1, DPP_XOR2 = 0x4E, DPP_HMIR = 0x141, DPP_ROR8 = 0x128;
constexpr int PEER_NSL = 16, PEER_SLD = 128;
constexpr int PEER_TPW = T_ / (32 * NWAVES);
static_assert(NWAVES * PEER_TPW * 128 * 4 <= LDS_BYTES - 16, "U pass: first-slice partial sums in LDS");
constexpr size_t WS_PART = WS_PD;
static_assert(WS_AG - WS_PD == 64 * MiB, "partial-sum region");
typedef __bf16 bf16x2_t __attribute__((ext_vector_type(2)));
DEV float dot4_fp8_bf16(unsigned w, unsigned h01, unsigned h23, float acc) {
    acc = __builtin_amdgcn_fdot2_f32_bf16(__builtin_amdgcn_cvt_scalef32_pk_bf16_fp8(w, 1.0f, false), __builtin_bit_cast(bf16x2_t, h01), acc, false);
    return __builtin_amdgcn_fdot2_f32_bf16(__builtin_amdgcn_cvt_scalef32_pk_bf16_fp8(w, 1.0f, true), __builtin_bit_cast(bf16x2_t, h23), acc, false);
}
DEV float dot4_fp8(unsigned w, float h0, float h1, float h2, float h3, float acc) {
    const f32x2 lo = __builtin_amdgcn_cvt_pk_f32_fp8((int)w, false), hi = __builtin_amdgcn_cvt_pk_f32_fp8((int)w, true);
    return acc + lo.x * h0 + lo.y * h1 + hi.x * h2 + hi.y * h3;
}
#define UNPACK_HF(HF, H0, H1) do { HF[0] = bf_lo(H0.x); HF[1] = bf_hi(H0.x); HF[2] = bf_lo(H0.y); HF[3] = bf_hi(H0.y); HF[4] = bf_lo(H0.z); HF[5] = bf_hi(H0.z); HF[6] = bf_lo(H0.w); HF[7] = bf_hi(H0.w); \
        HF[8] = bf_lo(H1.x); HF[9] = bf_hi(H1.x); HF[10] = bf_lo(H1.y); HF[11] = bf_hi(H1.y); HF[12] = bf_lo(H1.z); HF[13] = bf_hi(H1.z); HF[14] = bf_lo(H1.w); HF[15] = bf_hi(H1.w); } while (0)
struct PeerRowU { u32x4 h0, h1; int i0, i1; };
#define PEER_SU(R, TT) do { const int _t = t0 + min((TT), tpw - 1); const GAS bf16_t* _xr = sptr(xn + (size_t)_t * D_ + sl * PEER_SLD); R.h0 = gld<u32x4>(_xr, uj16 * 2u); R.h1 = gld<u32x4>(_xr, uj16 * 2u + 16u); \
        const GAS int* _ir = sptr(idx + (size_t)_t * 128); R.i0 = gld<int>(_ir, ulane * 4u); R.i1 = gld<int>(_ir, ulane * 4u + 256u); } while (0)
#define PEER_GU(UQ, R) do { _Pragma("unroll") for (int i = 0; i < 16; ++i) { const int e = __builtin_amdgcn_ds_bpermute(((i & 7) * 8 + g) << 2, (i < 8) ? R.i0 : R.i1); UQ[i] = *(const GAS u32x4*)(Ug + (sbase + ((unsigned)e << 7))); } } while (0)
#define PEER_CU(UQ, R, TT) do { float p[16]; \
        _Pragma("unroll") for (int i = 0; i < 16; ++i) { float d = dot4_fp8_bf16(UQ[i].x, R.h0.x, R.h0.y, 0.f); d = dot4_fp8_bf16(UQ[i].y, R.h0.z, R.h0.w, d); \
            d = dot4_fp8_bf16(UQ[i].z, R.h1.x, R.h1.y, d); d = dot4_fp8_bf16(UQ[i].w, R.h1.z, R.h1.w, d); \
            d += dppf<DPP_XOR1>(d); d += dppf<DPP_XOR2>(d); d += dppf<DPP_HMIR>(d); p[i] = d; } \
        float v0 = p[0], v1 = p[8]; \
        _Pragma("unroll") for (int i = 1; i < 8; ++i) { v0 = (j8 == i) ? p[i] : v0; v1 = (j8 == i) ? p[8 + i] : v1; } \
        if (COMMIT) { LAS float* lp = (LAS float*)F.lds + ((F.wave * PEER_TPW + (TT)) * 128 + (int)uslot);     \
            if (j == 0) { lp[0] = v0; lp[64] = v1; } \
            else { v0 += lp[0]; v1 += lp[64]; GAS bf16_t* po = sptr(part + ((size_t)xl * T_ + t0 + (TT)) * 128); gst<unsigned>(po, uslot * 4u, cvt_pk_bf16(v0, v1));     } \
        } else { asm volatile("" :: "v"(v0), "v"(v1)); } } while (0)
#define SB() __builtin_amdgcn_sched_barrier(0)
template <bool COMMIT, bool SIDE> DEV void phase_peer_u(const Frame& F, int layer) {
    const bf16_t* xn = WSP(bf16_t, WS_XN); const int* idx = WSP(int, WS_IDX);
    const GAS unsigned char* Ug = (const GAS unsigned char*)(WSP(unsigned char, WS_U16) + (size_t)layer * PEER_TBL);
    bf16_t* part = WSP(bf16_t, WS_PART);
    const int lane0 = F.lane, xl = F.c & 7, rk = F.c >> 3, nrk = F.G >> 3, tpw = T_ / (nrk * NWAVES);
    const int t0 = (rk * NWAVES + F.wave) * tpw;
#pragma unroll 1
    for (int j = 0; j < PEER_NSL / 8; ++j) {
        const int sl = xl + 8 * j;
        const unsigned sbase0 = (unsigned)sl * (unsigned)PEER_SLS;
        PeerRowU ra, rb, na, nb;
        u32x4 uqA[16], uqB[16];
        { int lane_o = lane0; asm volatile("" : "+v"(lane_o));
          const int lane = lane_o, g = lane >> 3, j8 = lane & 7; const unsigned ulane = (unsigned)lane, uj16 = (unsigned)j8 * 16u;
          const unsigned sbase = sbase0 + (unsigned)j8 * 16u;
          PEER_SU(ra, 0); PEER_SU(rb, 1); SB(); PEER_GU(uqA, ra); SB(); PEER_SU(na, 2); SB(); PEER_GU(uqB, rb); SB(); PEER_SU(nb, 3); SB(); }
#pragma unroll 1
        for (int tt = 0; tt < tpw; tt += 2) {
            int lane_o = lane0; asm volatile("" : "+v"(lane_o));
            const int lane = lane_o, g = lane >> 3, j8 = lane & 7; const unsigned ulane = (unsigned)lane, uj16 = (unsigned)j8 * 16u, uslot = (unsigned)(j8 * 8 + g);
            const unsigned sbase = sbase0 + (unsigned)j8 * 16u;
            const bool more = tt + 2 < tpw;
            PEER_CU(uqA, ra, tt); SB();
            ra = na;
            if (more) { PEER_GU(uqA, ra); }
            SB();
            PEER_SU(na, tt + 4); SB();
            PEER_CU(uqB, rb, tt + 1); SB();
            rb = nb;
            if (more) { PEER_GU(uqB, rb); }
            SB();
            PEER_SU(nb, tt + 5); SB();
        }
    }
}
DEV void phase_peer_act(const Frame& F, int layer) {
    const bf16_t* part = WSP(bf16_t, WS_PART); float* gate = WSP(float, WS_GATE); const ss_t* ssf = WSP(ss_t, WS_SS) + (size_t)(3 * layer + 1) * T_;
    const int tstep = F.G * NWAVES;
    for (int t = F.c * NWAVES + F.wave; t < T_; t += 2 * tstep) {
        unsigned w[2][PEER_NSL / 2]; float gv[2][2]; int iv[2][2]; float rs[2];
#pragma unroll
        for (int k = 0; k < 2; ++k) { const int tk = t + k * tstep;
#pragma unroll
            for (int sl = 0; sl < PEER_NSL / 2; ++sl) w[k][sl] = ((const unsigned*)(part + ((size_t)sl * T_ + tk) * 128))[F.lane];
            const float* gp = gate + (size_t)tk * 128; const int* ip = WSP(int, WS_IDX) + (size_t)tk * 128;
            gv[k][0] = gp[F.lane]; gv[k][1] = gp[64 + F.lane]; iv[k][0] = ip[F.lane]; iv[k][1] = ip[64 + F.lane];
            rs[k] = rstd_of(ssf[tk]) * (1.0f / PEER_U_SCALE); }
#pragma unroll
        for (int k = 0; k < 2; ++k) { const int tk = t + k * tstep; float h0 = 0.f, h1 = 0.f;
#pragma unroll
            for (int sl = 0; sl < PEER_NSL / 2; ++sl) { h0 += bf_lo(w[k][sl]); h1 += bf_hi(w[k][sl]); }
            unsigned* pk = (unsigned*)(gate + (size_t)tk * 128);
            const float a0 = gv[k][0] * gelu_erf(h0 * rs[k]) * (1.0f / PEER_V_SCALE), a1 = gv[k][1] * gelu_erf(h1 * rs[k]) * (1.0f / PEER_V_SCALE);
            pk[F.lane] = (cvt_pk_bf16(0.f, a0) & 0xffff0000u) | (unsigned)iv[k][0]; pk[64 + F.lane] = (cvt_pk_bf16(0.f, a1) & 0xffff0000u) | (unsigned)iv[k][1]; }
    }
}
#define PEER_ACC4(W, K) do { const f32x2 _lo = __builtin_amdgcn_cvt_pk_f32_fp8((int)(W), false), _hi = __builtin_amdgcn_cvt_pk_f32_fp8((int)(W), true); \
        acc2[(K) / 2] = a2 * _lo + acc2[(K) / 2]; acc2[(K) / 2 + 1] = a2 * _hi + acc2[(K) / 2 + 1]; } while (0)
struct PeerRowV { unsigned p0, p1; };
#define PEER_SV(R, TT) do { const int _t = t0 + min((TT), tpw - 1); const GAS unsigned* _pr = sptr(pkw + (size_t)_t * 128); \
        R.p0 = gld<unsigned>(_pr, ulane * 4u); R.p1 = gld<unsigned>(_pr, ulane * 4u + 256u); } while (0)
#define PEER_GV(VQ, AW, R) do { _Pragma("unroll") for (int i = 0; i < 16; ++i) { AW[i] = (unsigned)__builtin_amdgcn_ds_bpermute(((i & 7) * 8 + g) << 2, (int)((i < 8) ? R.p0 : R.p1)); \
        unsigned _off; asm("v_mad_u32_u16 %0, %1, %2, %3" : "=v"(_off) : "v"(AW[i]), "s"(128u), "v"(sbase));     \
        VQ[i] = *(const GAS u32x4*)(Vg + _off); } } while (0)
DEV float half_sum16(float a, float b) { const u32x2 r = __builtin_amdgcn_permlane16_swap(__float_as_uint(a), __float_as_uint(b), false, false); return __uint_as_float(r.x) + __uint_as_float(r.y); }
DEV float half_sum32(float a, float b) { const u32x2 r = __builtin_amdgcn_permlane32_swap(__float_as_uint(a), __float_as_uint(b), false, false); return __uint_as_float(r.x) + __uint_as_float(r.y); }
template <bool COMMIT> DEV void peer_cv(const u32x4 (&vq)[16], const unsigned (&aw)[16], unsigned hw, int t, int tl, float& ssacc, int sl, int lane, int g, int j8, bf16_t* hb) {
    f32x2 acc2[8];
#pragma unroll
    for (int k = 0; k < 8; ++k) acc2[k] = (f32x2){0.f, 0.f};
#pragma unroll
    for (int i = 0; i < 16; ++i) { const float a = __uint_as_float(aw[i] & 0xffff0000u); const f32x2 a2 = (f32x2){a, a};
        PEER_ACC4(vq[i].x, 0); PEER_ACC4(vq[i].y, 4); PEER_ACC4(vq[i].z, 8); PEER_ACC4(vq[i].w, 12); }
    float acc[16];
#pragma unroll
    for (int k = 0; k < 8; ++k) { acc[2 * k] = acc2[k].x; acc[2 * k + 1] = acc2[k].y; }
    float c8[8], c4[4], f0, f1;
#pragma unroll
    for (int k = 0; k < 8; ++k) c8[k] = half_sum32(acc[k], acc[8 + k]);
#pragma unroll
    for (int k = 0; k < 4; ++k) c4[k] = half_sum16(c8[k], c8[4 + k]);
    { const bool b3 = (lane & 8) != 0;
      const float k0 = b3 ? c4[2] : c4[0], k1 = b3 ? c4[3] : c4[1], s0 = b3 ? c4[0] : c4[2], s1 = b3 ? c4[1] : c4[3];
      f0 = k0 + dppf<DPP_ROR8>(s0); f1 = k1 + dppf<DPP_ROR8>(s1); }
    if (!COMMIT) { asm volatile("" :: "v"(f0), "v"(f1)); }
    else { GAS bf16_t* hbrow = sptr(hb + (size_t)t * D_ + sl * PEER_SLD);
        const float x0 = bf_lo(hw) + f0, x1 = bf_hi(hw) + f1;
        gst<unsigned>(hbrow, (unsigned)j8 * 32u + (unsigned)g * 4u, cvt_pk_bf16(x0, x1));
        float s2 = x0 * x0 + x1 * x1;
        s2 += dppf<DPP_XOR1>(s2); s2 += dppf<DPP_XOR2>(s2); s2 += dppf<DPP_HMIR>(s2); s2 += dppf<DPP_ROR8>(s2); s2 = sum_xor16(s2); s2 = sum_xor32(s2);
        ssacc = (lane == tl) ? s2 : ssacc; }
}
template <bool COMMIT> DEV void phase_peer_v(const Frame& F, int layer) {
    const unsigned* pkw = WSP(unsigned, WS_GATE);
    const GAS unsigned char* Vg = (const GAS unsigned char*)(WSP(unsigned char, WS_V16) + (size_t)layer * PEER_TBL);
    bf16_t* hb = WSP(bf16_t, WS_XN); ss_t* ssp = WSP(ss_t, WS_SS) + (size_t)(3 * layer + 2) * T_;
    const int lane0 = F.lane, xl = F.c & 7, rk = F.c >> 3, nrk = F.G >> 3, tpw = T_ / (nrk * NWAVES);
    const int t0 = (rk * NWAVES + F.wave) * tpw;
#pragma unroll 1
    for (int j = 0; j < PEER_NSL / 8; ++j) {
        const int sl = xl + 8 * j;
        const unsigned sbase0 = (unsigned)sl * (unsigned)PEER_SLS;
        PeerRowV ra, rb, na, nb; float ssacc = 0.f;
        { const unsigned ulane = (unsigned)lane0; PEER_SV(ra, 0); PEER_SV(rb, 1); }
#pragma unroll 1
        for (int tt = 0; tt < tpw; tt += 2) {
            int lane_o = lane0; asm volatile("" : "+v"(lane_o));
            const int lane = lane_o, g = lane >> 3, j8 = lane & 7, x32addr = (lane ^ 32) << 2; const unsigned ulane = (unsigned)lane;
            const unsigned sbase = sbase0 + (unsigned)j8 * 16u;
            unsigned hA, hB;
            { const GAS bf16_t* ha = sptr(hb + (size_t)(t0 + tt) * D_ + sl * PEER_SLD); const GAS bf16_t* hbp = sptr(hb + (size_t)(t0 + tt + 1) * D_ + sl * PEER_SLD);
              hA = gld<unsigned>(ha, (unsigned)j8 * 32u + (unsigned)g * 4u); hB = gld<unsigned>(hbp, (unsigned)j8 * 32u + (unsigned)g * 4u); }
            SB();
            u32x4 vqA[16], vqB[16]; unsigned awA[16], awB[16];
            PEER_GV(vqA, awA, ra); PEER_GV(vqB, awB, rb); SB();
            PEER_SV(na, tt + 2); PEER_SV(nb, tt + 3); SB();
            peer_cv<COMMIT>(vqA, awA, hA, t0 + tt, tt, ssacc, sl, lane, g, j8, hb); SB();
            peer_cv<COMMIT>(vqB, awB, hB, t0 + tt + 1, tt + 1, ssacc, sl, lane, g, j8, hb); SB();
            ra = na; rb = nb;
        }
        if (COMMIT && lane0 < tpw) { GAS ss_t* sp = sptr(ssp + t0); const ss_t sv = ss_fix(ssacc); const unsigned zoff = (unsigned)lane0 * 8u; asm volatile("global_atomic_add_x2 %0, %1, %2" :: "v"(zoff), "v"(sv), "s"(sp)); }
    }
}

enum { K_FILT = 0, K_PPROJ, K_POOLIN, K_GATES, K_HYT, K_WCOMB, K_AG, K_MIX, K_RES, K_WQK, K_SCORES, K_PLE };

#define KM(k) (1u << (k))
DEV unsigned gate_pk4(f32x4 g) { return (unsigned)(g[0] * 255.0f + 0.5f) | ((unsigned)(g[1] * 255.0f + 0.5f) << 8) | ((unsigned)(g[2] * 255.0f + 0.5f) << 16) | ((unsigned)(g[3] * 255.0f + 0.5f) << 24); }
DEV f32x4 gate_un4(unsigned q) { return (f32x4){(float)(q & 255u), (float)((q >> 8) & 255u), (float)((q >> 16) & 255u), (float)(q >> 24)} * (1.0f / 255.0f); }
template <unsigned KINDS> struct EpiAll {
    unsigned char* ws; const float* x_in; const float* pool_scale; int layer;
    const ss_t* ss_in;
    ss_t* ss_out;
    LAS unsigned char* lds = nullptr;
    template <unsigned K> static constexpr bool has() { return (KINDS & KM(K)) != 0u; }
    static constexpr int GROUP_ROWS = 4;
    __device__ __forceinline__ void unit_begin(const Unit& u, int wr, int wc, int fr, int fq, pg8::EpiCtx& c) const {
        if constexpr (has<K_POOLIN>() || has<K_GATES>() || has<K_PLE>()) if (u.kind == K_POOLIN || u.kind == K_GATES || u.kind == K_PLE) {
#pragma unroll
            for (int r8 = 0; r8 < 8; ++r8) c.rs[r8] = rstd_of(ss_in[u.i0 + (r8 >> 2) * 128 + wr * 64 + (r8 & 3) * 16 + fr]);
        }
        if constexpr (has<K_HYT>() || has<K_SCORES>()) if (u.kind == K_HYT || u.kind == K_SCORES) {
#pragma unroll
            for (int bj = 0; bj < 2; ++bj) { const ss_t* sp = ss_in + u.i1 + bj * 128 + wc * 32 + 8 * fq;
#pragma unroll
                for (int k = 0; k < 8; ++k) c.cs[bj * 8 + k] = rstd_of(sp[k]); }
        }
        if constexpr (has<K_SCORES>()) if (u.kind == K_SCORES) { asm volatile("s_waitcnt vmcnt(0)" ::: "memory"); __syncthreads(); }
    }
    __device__ __forceinline__ void pre(const Unit& u, int row, int col, pg8::EpiPre& p) const {
        const int R = u.i0 + row, C = u.i1 + col;
        if constexpr (has<K_AG>()) if (u.kind == K_AG) { const u32x2 q = *(const u32x2*)((const unsigned char*)(ws + WS_GATES) + (size_t)R * 4096 + C); p.a.x = q.x; p.a.y = q.y; }
        if constexpr (has<K_MIX>()) if (u.kind == K_MIX) { const u32x2 q = *(const u32x2*)((const unsigned char*)(ws + WS_GATES) + (size_t)R * 4096 + 2048 + C); p.a.x = q.x; p.a.y = q.y; p.b = *(const u32x4*)((const bf16_t*)(ws + WS_AG) + (size_t)R * D_ + C); }
        if constexpr (has<K_RES>()) if (u.kind == K_RES) { if (layer == 0) { const u32x4* hi = (const u32x4*)(x_in + (size_t)R * D_ + C); p.a = hi[0]; p.b = hi[1]; }
            else p.a = *(const u32x4*)((const bf16_t*)(ws + WS_HB1) + (size_t)R * D_ + C); }
        if constexpr (has<K_PLE>()) if (u.kind == K_PLE) { p.a = *(const u32x4*)((const bf16_t*)(ws + WS_XN) + (size_t)R * D_ + C);
            p.c = *(const u32x4*)((const bf16_t*)(ws + WS_PPROJ) + ((size_t)layer * T_ + R) * D_ + C); }
    }
    __device__ __forceinline__ float store(const Unit& u, int row, int col, f32x4 v0, f32x4 v1, const pg8::EpiPre& p, const pg8::EpiCtx& c, int r8, int bj) const {
        const int R = u.i0 + row, C = u.i1 + col;
        switch (u.kind) {
        case K_FILT: if constexpr (has<K_FILT>()) { _Float16* o = (_Float16*)(ws + WS_FILT) + ((size_t)u.i2 * 4096 + R) * 2048 + C;
                      typedef _Float16 f16x8_t __attribute__((ext_vector_type(8)));
                      const f16x8_t hv = {(_Float16)v0[0], (_Float16)v0[1], (_Float16)v0[2], (_Float16)v0[3], (_Float16)v1[0], (_Float16)v1[1], (_Float16)v1[2], (_Float16)v1[3]};
                      *(f16x8_t*)o = hv; } break;
        case K_PPROJ: if constexpr (has<K_PPROJ>()) st_bf16x8((bf16_t*)(ws + WS_PPROJ) + ((size_t)u.i2 * T_ + R) * D_ + C, v0, v1); break;
        case K_POOLIN: if constexpr (has<K_POOLIN>()) { const float r = c.rs[r8]; st_bf16x8((bf16_t*)(ws + WS_POOLIN) + (size_t)R * PW_ + C, v0 * r, v1 * r); } break;
        case K_GATES: if constexpr (has<K_GATES>()) { const float r = c.rs[r8]; u32x2 q; q.x = gate_pk4(sig4(v0 * r)); q.y = gate_pk4(sig4(v1 * r)); *(u32x2*)((unsigned char*)(ws + WS_GATES) + (size_t)R * 4096 + C) = q; } break;
        case K_HYT: if constexpr (has<K_HYT>()) { const f32x4 r0 = (f32x4){c.cs[bj * 8 + 0], c.cs[bj * 8 + 1], c.cs[bj * 8 + 2], c.cs[bj * 8 + 3]}, r1 = (f32x4){c.cs[bj * 8 + 4], c.cs[bj * 8 + 5], c.cs[bj * 8 + 6], c.cs[bj * 8 + 7]};
                      st_bf16x8((bf16_t*)(ws + WS_HYT) + (size_t)R * T_ + C, v0 * r0, v1 * r1); } break;
        case K_WCOMB: if constexpr (has<K_WCOMB>()) st_bf16x8((bf16_t*)(ws + WS_WCOMB) + ((size_t)u.i2 * D_ + R) * PW_ + C, v0, v1); break;
        case K_AG: if constexpr (has<K_AG>()) { const f32x4 g0 = gate_un4(p.a.x), g1 = gate_un4(p.a.y); st_bf16x8((bf16_t*)(ws + WS_AG) + (size_t)R * D_ + C, v0 * g0, v1 * g1); } break;
        case K_MIX: if constexpr (has<K_MIX>()) { f32x4 a0, a1; const f32x4 g0 = gate_un4(p.a.x), g1 = gate_un4(p.a.y); unpk8(p.b, a0, a1); st_bf16x8((bf16_t*)(ws + WS_MIX) + (size_t)R * D_ + C, a0 + v0 * g0, a1 + v1 * g1); } break;
        case K_RES: if constexpr (has<K_RES>()) { f32x4 x0, x1; if (layer == 0) { x0 = __builtin_bit_cast(f32x4, p.a); x1 = __builtin_bit_cast(f32x4, p.b); } else unpk8(p.a, x0, x1);
                      const f32x4 h0 = x0 + v0, h1 = x1 + v1;
                      st_bf16x8((bf16_t*)(ws + WS_XN) + (size_t)R * D_ + C, h0, h1); return ssq8(h0, h1); } break;
        case K_WQK: if constexpr (has<K_WQK>()) st_bf16x8((bf16_t*)(ws + WS_WQK) + ((size_t)u.i2 + R) * D_ + C, v0, v1); break;
        case K_SCORES: if constexpr (has<K_SCORES>()) { LAS _Float16* o = (LAS _Float16*)lds + row * SC_LD + col;
                      const f32x4 s0 = v0 * (f32x4){c.cs[bj * 8 + 0], c.cs[bj * 8 + 1], c.cs[bj * 8 + 2], c.cs[bj * 8 + 3]}, s1 = v1 * (f32x4){c.cs[bj * 8 + 4], c.cs[bj * 8 + 5], c.cs[bj * 8 + 6], c.cs[bj * 8 + 7]};
                      typedef _Float16 f16x8_t __attribute__((ext_vector_type(8)));
                      const f16x8_t hv = {(_Float16)s0[0], (_Float16)s0[1], (_Float16)s0[2], (_Float16)s0[3], (_Float16)s1[0], (_Float16)s1[1], (_Float16)s1[2], (_Float16)s1[3]};
                      *(LAS f16x8_t*)o = hv; } break;
        case K_PLE: if constexpr (has<K_PLE>()) { f32x4 p0, p1, x0, x1; unpk8(p.c, p0, p1); unpk8(p.a, x0, x1); const float r = c.rs[r8];
                      const f32x4 h0 = x0 + sig4(v0 * r) * p0, h1 = x1 + sig4(v1 * r) * p1;
                      st_bf16x8((bf16_t*)(ws + WS_HB1) + (size_t)R * D_ + C, h0, h1); return ssq8(h0, h1); } break;
        }
        return 0.f;
    }
    __device__ __forceinline__ void row_done(const Unit& u, int row, float ssq, int lane) const {
        if constexpr ((KINDS & (KM(K_RES) | KM(K_PLE))) != 0u) if (u.kind == K_RES || u.kind == K_PLE) {
            ssq += swz_xor16(ssq);
            ssq += __builtin_bit_cast(float, __builtin_amdgcn_ds_bpermute((lane ^ 32) << 2, __builtin_bit_cast(int, ssq)));
            if (lane < 16) atomicAdd(ss_out + u.i0 + row, ss_fix(ssq));
        }
    }
};

#define TILE_BYTES(ld) ((size_t)256 * (ld) * 2)
struct DecP0b {
    unsigned char* ws;
    __device__ __forceinline__ void decode(int idx, Unit& u) const {
        if (idx < 256) { const int l = idx >> 7, r = idx & 127, pm = r >> 3, pn = r & 7;
            u.a = (const char*)(ws + WS_W3A) + (size_t)l * 4096 * 512 + (size_t)pm * TILE_BYTES(256); u.b = (const char*)(ws + WS_HB) + (size_t)l * 2048 * 512 + (size_t)pn * TILE_BYTES(256);
            u.kind = K_FILT; u.i0 = pm * 256; u.i1 = pn * 256; u.i2 = l; }
        else { const int v = idx - 256, l = v >> 8, r = v & 255, pm = r & 31, pn = r >> 5;
            u.a = (const char*)(ws + WS_P16) + (size_t)l * T_ * 512 + (size_t)pm * TILE_BYTES(256); u.b = (const char*)(ws + WS_WP_T) + (size_t)l * D_ * 512 + (size_t)pn * TILE_BYTES(256);
            u.kind = K_PPROJ; u.i0 = pm * 256; u.i1 = pn * 256; u.i2 = l; }
    }
};
struct DecG1 {
    unsigned char* ws; int layer;
    __device__ __forceinline__ void decode(int idx, Unit& u) const {
        const char* xn = (const char*)(ws + (layer == 0 ? WS_XN : WS_HB1)); const char* w = (const char*)(ws + WS_WIN_T) + (size_t)layer * INC_ * D_ * 2;
        if (idx < 640) { const int pm = idx & 31, j = idx >> 5, pnw = (j < 4) ? j : j + 12;
            u.a = xn + (size_t)pm * TILE_BYTES(D_); u.b = w + (size_t)pnw * TILE_BYTES(D_);
            if (j < 4) { u.kind = K_POOLIN; u.i0 = pm * 256; u.i1 = pnw * 256; } else { u.kind = K_GATES; u.i0 = pm * 256; u.i1 = (pnw - 16) * 256; }
            u.i2 = 0; }
        else { const int v = idx - 640, pn = v & 31, pmw = 4 + (v >> 5);
            u.a = w + (size_t)pmw * TILE_BYTES(D_); u.b = xn + (size_t)pn * TILE_BYTES(D_);
            u.kind = K_HYT; u.i0 = (pmw - 4) * 256; u.i1 = pn * 256; u.i2 = 0; }
    }
};
struct DecSimple {
    const char* A; const char* B; int lda, ldb, nM, kind, a_col_step  , b_tile_rows  ;
    __device__ __forceinline__ void decode(int idx, Unit& u) const {
        const int pm = idx % nM, pn = idx / nM;
        u.a = A + (size_t)pm * TILE_BYTES(lda) + (size_t)pn * a_col_step; u.b = B + (size_t)pn * b_tile_rows * ldb * 2;
        u.kind = kind; u.i0 = pm * 256; u.i1 = pn * 256; u.i2 = 0;
    }
};

struct DecScores {
    unsigned char* ws; int layer;
    __device__ __forceinline__ void decode(int idx, Unit& u) const {
        const int pn = idx & 31, h = idx >> 5;
        u.a = (const char*)(ws + WS_WQK) + ((size_t)layer * D_ + h * 256) * D_ * 2; u.b = (const char*)(ws + WS_XN) + (size_t)pn * TILE_BYTES(D_);
        u.kind = K_SCORES; u.i0 = 0; u.i1 = pn * 256; u.i2 = h;
    }
};
struct DecWqk {
    unsigned char* ws;
    __device__ __forceinline__ void decode(int idx, Unit& u) const {
        const int l = idx >> 6, h = (idx >> 3) & 7, pn = idx & 7;
        u.a = (const char*)(ws + WS_KBD) + (size_t)l * 65536 * 2; u.b = (const char*)(ws + WS_WQ_T) + ((size_t)l * D_ + pn * 256) * D_ * 2 + (size_t)h * 512;
        u.kind = K_WQK; u.i0 = 0; u.i1 = pn * 256; u.i2 = l * D_ + h * 256;
    }
};
struct DecWcomb {
    unsigned char* ws;
    __device__ __forceinline__ void decode(int idx, Unit& u) const {
        const int l = idx >> 5, g = (idx >> 3) & 3, pm = idx & 7;
        u.a = (const char*)(ws + WS_WPO_T) + ((size_t)l * D_ + pm * 256) * PW_ * 2 + (size_t)g * 512; u.b = (const char*)(ws + WS_WPOOL) + (size_t)(l * 4 + g) * 65536 * 2;
        u.kind = K_WCOMB; u.i0 = pm * 256; u.i1 = g * 256; u.i2 = l;
    }
};
template <unsigned KINDS, class Dec> DEV void run_gemm(const Frame& F, const Dec& d, int total, int K, int lda, int ldb, const EpiAll<0xFFFFu>& e0, int c_shift = 0) {
    FlatSched<Dec> S{d, total, F.G, F.c - c_shift};
    const pg8::Epi<EpiAll<KINDS>> E{EpiAll<KINDS>{e0.ws, e0.x_in, e0.pool_scale, e0.layer, e0.ss_in, e0.ss_out, F.lds}};
    int tid = F.tid; asm volatile("" : "+v"(tid));
    pg8::gemm_phase<pg8::Epi<EpiAll<KINDS>>, FlatSched<Dec>>(F.lds, tid, pg8::Gemm{K, lda, ldb}, S, E);
}

template <int S> DEV void run_step(Frame F, int l) {
    asm volatile("" : "+s"(F.P));
    { int ln; asm volatile("v_mbcnt_lo_u32_b32 %0, -1, 0\n\tv_mbcnt_hi_u32_b32 %0, -1, %0" : "=v"(ln)); asm volatile("" : "+s"(F.wave)); F.lane = ln; F.tid = F.wave * 64 + ln; }
    asm volatile("" : "+s"(F.c), "+s"(F.G));
    unsigned char* ws = F.ws;
    if constexpr (S == 100) {
        for (int r = 0; r < REP_P0T; ++r) p0_transposes(F);
        for (int r = 0; r < REP_P0S; ++r) {
        convert_bf16(F, F.P->in[1], WSP(bf16_t, WS_P16), (size_t)2 * T_ * PLE_);
        convert_bf16(F, F.P->in[4], WSP(bf16_t, WS_WPOOL), (size_t)2 * 4 * 65536);
        for (int ll = 0; ll < 2; ++ll) convert_rows(F, F.P->in[19] + (size_t)ll * D_ * D_, WSP(bf16_t, WS_WQ_T) + (size_t)ll * D_ * D_, D_, D_, F.P->in[18] + (size_t)ll * D_);
        p0_small(F);
        p0_hdn(F);
        phase_rowstat(F, F.P->in[0], WSP(bf16_t, WS_XN), WSP(ss_t, WS_SS));
        }
    } else if constexpr (S == 102) {
        phase_final_norm(F, WSP(bf16_t, WS_HB1), F.P->in[27], F.out);
    } else {
        const float* hin = (l == 0) ? F.P->in[0] : WSP(float, WS_H);
        ss_t* SS = WSP(ss_t, WS_SS);
        const int ssi = (S == 1) ? 3 * l : (S == 8) ? 3 * l + 1 : 3 * l + 2, sso = (S == 6) ? 3 * l + 1 : 3 * l + 3;
        const EpiAll<0xFFFFu> E{ws, hin, F.P->in[5] + (size_t)l * PW_, l, SS + (size_t)ssi * T_, SS + (size_t)(sso > 6 ? 6 : sso) * T_};
        if constexpr (S == 1) {
            if (l == 0) {
                run_gemm<KM(K_FILT) | KM(K_PPROJ)>(F, DecP0b{ws}, 768, 256, 256, 256, E);
                run_gemm<KM(K_WQK)>(F, DecWqk{ws}, 128, 256, 256, D_, E);
                run_gemm<KM(K_WCOMB)>(F, DecWcomb{ws}, 64, 256, PW_, 256, E, 128);
            }
            run_gemm<KM(K_POOLIN) | KM(K_GATES) | KM(K_HYT)>(F, DecG1{ws, l}, 1024, D_, D_, D_, E);
        }
        else if constexpr (S == 2) { phase_pooldiff(F); phase_hyena(F, l); }
        else if constexpr (S == 4) { phase_z2_transpose(F);
            run_gemm<KM(K_AG)>(F, DecSimple{(const char*)(ws + WS_PD), (const char*)(ws + WS_WCOMB) + (size_t)l * D_ * PW_ * 2, PW_, PW_, 32, K_AG, 0, 256}, 256, PW_, PW_, PW_, E); }
        else if constexpr (S == 5) run_gemm<KM(K_MIX)>(F, DecSimple{(const char*)(ws + WS_Z2), (const char*)(ws + WS_WHO_T) + (size_t)l * D_ * HW_ * 2, HW_, HW_, 32, K_MIX, 0, 256}, 256, HW_, HW_, HW_, E);
        else if constexpr (S == 6) run_gemm<KM(K_RES)>(F, DecSimple{(const char*)(ws + WS_MIX), (const char*)(ws + WS_WO_T) + (size_t)l * D_ * D_ * 2, D_, D_, 32, K_RES, 0, 256}, 256, D_, D_, D_, E);
        else if constexpr (S == 8) { run_gemm<KM(K_SCORES)>(F, DecScores{ws, l}, 256, D_, D_, D_, E); phase_topk(F); }
        else if constexpr (S == 11) phase_peer_u<true, false>(F, l);
        else if constexpr (S == 17) phase_peer_u<false, false>(F, l);
        else if constexpr (S == 14) phase_peer_act(F, l);
        else if constexpr (S == 15) phase_peer_v<true>(F, l);
        else if constexpr (S == 16) phase_peer_v<false>(F, l);
        else if constexpr (S == 13) run_gemm<KM(K_PLE)>(F, DecSimple{(const char*)(ws + WS_XN), (const char*)(ws + WS_WG_T) + (size_t)l * D_ * D_ * 2, D_, D_, 32, K_PLE, 0, 256}, 256, D_, D_, D_, E);
    }
}

template <int S> __global__ void __launch_bounds__(NTHREADS, 2) mk_step(Params p) {
    extern __shared__ __attribute__((aligned(16))) unsigned char lds_raw[];
    Frame F{(LAS unsigned char*)lds_raw, (int)threadIdx.x, (int)(threadIdx.x & 63), __builtin_amdgcn_readfirstlane((int)(threadIdx.x >> 6)), (int)blockIdx.x, (int)gridDim.x, (const __attribute__((address_space(4))) Params*)__builtin_amdgcn_kernarg_segment_ptr(), p.out, p.ws};
    run_step<S>(F, p.layer);
}


#if MK_ONE_LAUNCH
__global__ void __launch_bounds__(NTHREADS, 2) mk_fwd(Params p) {
    extern __shared__ __attribute__((aligned(16))) unsigned char lds_raw[];
    Frame F{(LAS unsigned char*)lds_raw, (int)threadIdx.x, (int)(threadIdx.x & 63), __builtin_amdgcn_readfirstlane((int)(threadIdx.x >> 6)), (int)blockIdx.x, (int)gridDim.x, (const __attribute__((address_space(4))) Params*)__builtin_amdgcn_kernarg_segment_ptr(), p.out, p.ws};
    volatile LAS unsigned* st = (volatile LAS unsigned*)(F.lds + LDS_BYTES - 16);
    if (F.tid == 0) { st[0] = 0u; st[1] = 0u; st[2] = 0u; st[3] = 0u; }
    __syncthreads();
    const XcdBarrier bar = xcd_barrier_post((unsigned*)(p.ws + WS_CTL), st);
#define SEAM() xcd_barrier(bar)
#define RUN(S, l, R) do { if ((R) == 1) { run_step<S>(F, l); SEAM(); } else if ((R) > 1) { _Pragma("unroll 1") for (int _r = 0; _r < (R); ++_r) { run_step<S>(F, l); SEAM(); } } } while (0)
#define LAYER(l) do { RUN(1, l, REP_G1); RUN(2, l, REP_HY); RUN(4, l, REP_GS); RUN(5, l, REP_GS); RUN(6, l, 1); RUN(8, l, REP_GQ); \
        RUN(17, l, REP_PUD - 1); RUN(11, l, REP_PU); RUN(14, l, 1); RUN(16, l, REP_PV - 1); RUN(15, l, 1); RUN(13, l, 1); } while (0)
    RUN(100, 0, REP_P0);
    LAYER(0);
    LAYER(1);
    run_step<102>(F, 0);
#undef SEAM
}
#endif

template <int S> static bool launch_step(Params& p, int layer, int grid, hipStream_t stream) {
    static bool attr = false;
    if (!attr) { if (hipFuncSetAttribute((const void*)mk_step<S>, hipFuncAttributeMaxDynamicSharedMemorySize, LDS_BYTES) != hipSuccess) { fprintf(stderr, "kernel_launch: hipFuncSetAttribute failed (step %d)\n", S); return false; } attr = true; }
    p.layer = layer;
    hipLaunchKernelGGL(mk_step<S>, dim3(grid), dim3(NTHREADS), LDS_BYTES, stream, p);
    return true;
}

extern "C" void kernel_launch(void* const* d_in, const int* in_sizes, int n_in, void* d_out, int out_size, void* d_ws, size_t ws_size, hipStream_t stream) {
    static int grid = 0;
    if (grid == 0) {
        if (n_in != 28 || out_size != T_ * D_ || ws_size < WS_END2) { fprintf(stderr, "kernel_launch: unexpected shapes (n_in %d, out %d, ws %zu, need %zu)\n", n_in, out_size, ws_size, (size_t)WS_END2); grid = -1; return; }
        int dev = 0, cus = 0;
        (void)hipGetDevice(&dev); (void)hipDeviceGetAttribute(&cus, hipDeviceAttributeMultiprocessorCount, dev);
        if (cus != 256) fprintf(stderr, "kernel_launch: built for a 256-CU device (one workgroup per CU, unit maps of 256); this device reports %d\n", cus);
        grid = 256;
    }
    if (grid < 0) return;
    Params p{};
    for (int i = 0; i < 28; ++i) p.in[i] = (const float*)d_in[i];
    p.out = (float*)d_out; p.ws = (unsigned char*)d_ws;
#if MK_ONE_LAUNCH
    static bool attr = false;
    if (!attr) { if (hipFuncSetAttribute((const void*)mk_fwd, hipFuncAttributeMaxDynamicSharedMemorySize, LDS_BYTES) != hipSuccess) { fprintf(stderr, "kernel_launch: hipFuncSetAttribute failed\n"); return; } attr = true; }
    if (hipMemsetAsync((char*)d_ws + WS_CTL, 0, XCD_BAR_WORDS * 4, stream) != hipSuccess) { fprintf(stderr, "kernel_launch: memset failed\n"); return; }
    hipLaunchKernelGGL(mk_fwd, dim3(grid), dim3(NTHREADS), LDS_BYTES, stream, p);
#else
    launch_step<100>(p, 0, grid, stream);
    for (int l = 0; l < DEPTH_; ++l) {
        launch_step<1>(p, l, grid, stream); launch_step<2>(p, l, grid, stream); launch_step<4>(p, l, grid, stream);
        launch_step<5>(p, l, grid, stream); launch_step<6>(p, l, grid, stream); launch_step<8>(p, l, grid, stream);
        launch_step<11>(p, l, grid, stream); launch_step<14>(p, l, grid, stream); launch_step<15>(p, l, grid, stream);
        launch_step<13>(p, l, grid, stream);
    }
    launch_step<102>(p, 0, grid, stream);
#endif
}
```

```cpp
#include <hip/hip_runtime.h>
#include <cstdio>
#include <cstdint>

#ifndef MK_ONE_LAUNCH
#define MK_ONE_LAUNCH 1
#endif

#ifndef REP_P0
#define REP_P0 1
#endif
#ifndef REP_P0B
#define REP_P0B 1
#endif
#ifndef REP_NORM
#define REP_NORM 1
#endif
#ifndef REP_G1
#define REP_G1 1
#endif
#ifndef REP_HY
#define REP_HY 1
#endif
#ifndef REP_GS
#define REP_GS 1
#endif
#ifndef REP_GQ
#define REP_GQ 1
#endif
#ifndef REP_TOPK
#define REP_TOPK 1
#endif
#ifndef REP_PU
#define REP_PU 1
#endif
#ifndef REP_PV
#define REP_PV 1
#endif
#ifndef REP_PUD
#define REP_PUD 1
#endif
#ifndef REP_P0T
#define REP_P0T 1
#endif
#ifndef REP_P0C
#define REP_P0C 1
#endif
#ifndef REP_P0S
#define REP_P0S 1
#endif
#define LAS __attribute__((address_space(3)))
#define HD __host__ __device__ __forceinline__
#define DEV __device__ __forceinline__

typedef unsigned short bf16_t;
typedef short bf16x8 __attribute__((ext_vector_type(8)));
typedef float f32x4 __attribute__((ext_vector_type(4)));
typedef unsigned u32x4 __attribute__((ext_vector_type(4)));
typedef unsigned u32x2 __attribute__((ext_vector_type(2)));

constexpr int T_ = 8192, D_ = 2048, L_ = 2048, NB_ = 4, DEPTH_ = 2;
constexpr int PLE_ = 256, INC_ = 8192, HW_ = 1024, PW_ = 1024;
constexpr int NEXP_ = 16384;
constexpr float EPS_ = 1e-6f;
constexpr int NTHREADS = 512, NWAVES = 8;
constexpr int LDS_BYTES = 147456;
constexpr int SC_LD = 264;
static_assert(256 * SC_LD * 2 + 16 <= LDS_BYTES, "score tile");

constexpr size_t MiB = 1ull << 20;
constexpr size_t WS_CTL    = 0;
constexpr size_t WS_SS     = 65536;
constexpr size_t WS_SSP    = 512 * 1024;
constexpr size_t WS_WIN_T  = 1 * MiB;
constexpr size_t WS_WPOOL  = WS_WIN_T + 64 * MiB;
constexpr size_t WS_WPO_T  = WS_WPOOL + 1 * MiB;
constexpr size_t WS_WHO_T  = WS_WPO_T + 8 * MiB;
constexpr size_t WS_WO_T   = WS_WHO_T + 8 * MiB;
constexpr size_t WS_WQ_T   = WS_WO_T + 16 * MiB;
constexpr size_t WS_WG_T   = WS_WQ_T + 16 * MiB;
constexpr size_t WS_WP_T   = WS_WG_T + 16 * MiB;
constexpr size_t WS_KBD    = WS_WP_T + 2 * MiB;
constexpr size_t WS_HB     = WS_KBD + 1 * MiB;
constexpr size_t WS_W3A    = WS_HB + 2 * MiB;
constexpr size_t WS_P16    = WS_W3A + 4 * MiB;
constexpr size_t WS_U16    = WS_P16 + 8 * MiB;
constexpr size_t WS_V16    = WS_U16 + 128 * MiB;
constexpr size_t WS_PPROJ  = WS_V16 + 128 * MiB;
constexpr size_t WS_FILT   = WS_PPROJ + 64 * MiB;
constexpr size_t WS_H      = WS_FILT + 64 * MiB;
constexpr size_t WS_XN     = WS_H + 64 * MiB;
constexpr size_t WS_POOLIN = WS_XN + 32 * MiB;
constexpr size_t WS_HYT    = WS_POOLIN + 16 * MiB;
constexpr size_t WS_GATES  = WS_HYT + 48 * MiB;
constexpr size_t WS_PD     = WS_GATES + 64 * MiB;
constexpr size_t WS_APRE   = WS_PD + 16 * MiB;
constexpr size_t WS_Z2T    = WS_APRE + 16 * MiB;
constexpr size_t WS_Z2     = WS_Z2T + 16 * MiB;
constexpr size_t WS_AG     = WS_Z2 + 16 * MiB;
constexpr size_t WS_MIX    = WS_AG + 32 * MiB;
constexpr size_t WS_IDX    = WS_MIX + 32 * MiB;
constexpr size_t WS_GATE   = WS_IDX + 4 * MiB;
constexpr size_t WS_END    = WS_GATE + 4 * MiB;
constexpr size_t WS_WQK    = WS_END;
constexpr size_t WS_WCOMB  = WS_WQK + 16 * MiB;
constexpr size_t WS_END2   = WS_WCOMB + 8 * MiB;
constexpr size_t WS_HB1    = WS_H;

struct Params { const float* in[28]; float* out; unsigned char* ws; int layer, pad; };

DEV unsigned cvt_pk_bf16(float lo, float hi) { unsigned r; asm volatile("v_cvt_pk_bf16_f32 %0, %1, %2" : "=v"(r) : "v"(lo), "v"(hi)); return r; }
DEV float bf_lo(unsigned u) { return __uint_as_float(u << 16); }
DEV float bf_hi(unsigned u) { return __uint_as_float(u & 0xffff0000u); }
DEV float bf1(bf16_t u) { return __uint_as_float(((unsigned)u) << 16); }
DEV bf16_t f2bf(float f) { return (bf16_t)(cvt_pk_bf16(f, 0.f) & 0xffffu); }
template <int CTRL> DEV float dpp_f(float x) { return __builtin_bit_cast(float, __builtin_amdgcn_mov_dpp(__builtin_bit_cast(int, x), CTRL, 0xf, 0xf, true)); }
DEV float sum_xor16(float x) { const u32x2 r = __builtin_amdgcn_permlane16_swap(__float_as_uint(x), __float_as_uint(x), false, false); return __uint_as_float(r.x) + __uint_as_float(r.y); }
DEV float sum_xor32(float x) { const u32x2 r = __builtin_amdgcn_permlane32_swap(__float_as_uint(x), __float_as_uint(x), false, false); return __uint_as_float(r.x) + __uint_as_float(r.y); }
DEV float swz_xor16(float x) { return __builtin_bit_cast(float, __builtin_amdgcn_ds_swizzle(__builtin_bit_cast(int, x), 0x401F)); }
DEV float wave_sum(float v) {
    v += dpp_f<0xB1>(v); v += dpp_f<0x4E>(v); v += dpp_f<0x141>(v); v += dpp_f<0x140>(v); v += swz_xor16(v);
    return __int_as_float(__builtin_amdgcn_readlane(__float_as_int(v), 0)) + __int_as_float(__builtin_amdgcn_readlane(__float_as_int(v), 32));
}
DEV void unpk8(u32x4 q, f32x4& v0, f32x4& v1) { v0 = (f32x4){bf_lo(q.x), bf_hi(q.x), bf_lo(q.y), bf_hi(q.y)}; v1 = (f32x4){bf_lo(q.z), bf_hi(q.z), bf_lo(q.w), bf_hi(q.w)}; }
DEV float ssq8(f32x4 a, f32x4 b) { return a[0] * a[0] + a[1] * a[1] + a[2] * a[2] + a[3] * a[3] + b[0] * b[0] + b[1] * b[1] + b[2] * b[2] + b[3] * b[3]; }
typedef unsigned long long ss_t;
DEV ss_t ss_fix(float s) { return (ss_t)(s * 16777216.0f + 0.5f); }
DEV float rstd_of(ss_t ss) { return __builtin_amdgcn_rsqf((float)ss * (1.0f / 16777216.0f / D_) + EPS_); }
DEV float sigmoidf_(float x) { return __builtin_amdgcn_rcpf(1.0f + __expf(-x)); }
DEV float gelu_erf(float x) { return 0.5f * x * (1.0f + erff(x * 0.70710678118654752f)); }

#ifndef GEMM_SP2
#define GEMM_SP2 true
#endif
#ifndef GEMM_ALIGN
#define GEMM_ALIGN true
#endif
namespace pg8 {
constexpr int BM = 256, BK = 64, HALF = 128, HTB = HALF * BK * 2, STAGE_BYTES = 8 * HTB;
HD int lds_byte(int r, int c) { const int st = (r >> 4) * 2 + (c >> 5), rr = r & 15, cc = c & 31, ob = rr * 64 + cc * 2; return st * 1024 + (ob ^ (((ob >> 9) & 1) << 5)); }
HD void stage_rc(int b, int& R, int& C) { const int st = b / 1024, sb = b % 1024, swz = sb ^ (((sb >> 9) & 1) << 5); R = (st >> 1) * 16 + swz / 64; C = (st & 1) * 32 + (swz % 64) / 2; }
HD int perm32(int rho) { const int n = rho >> 4, i = rho & 15; return 8 * (i >> 2) + 4 * n + (i & 3); }

struct Unit { const char* a; const char* b; int kind, i0, i1, i2; };
struct Gemm { int K, lda, ldb; };

template <class Epi, class Sched, bool ALIGN_EPI = GEMM_ALIGN, bool SP2 = GEMM_SP2>
__device__ __forceinline__ void gemm_phase(LAS unsigned char* lds, const int tid, const Gemm g, const Sched& S, const Epi& E) {
    const int wid = __builtin_amdgcn_readfirstlane(tid >> 6), lane = tid & 63, wr = wid >> 2, wc = wid & 3, fr = lane & 15, fq = lane >> 4;
    const int K = g.K, nt = K / BK;
    unsigned voffA[2], voffB[2];
#pragma unroll
    for (int i = 0; i < 2; ++i) { int R, C; stage_rc(tid * 16 + i * 8192, R, C); const int Rb = (R & ~31) + perm32(R & 31);
        voffA[i] = (unsigned)(R * g.lda + C) * 2u; voffB[i] = (unsigned)(Rb * g.ldb + C) * 2u; }
    const size_t kstep = (size_t)(BK * 2);
    const size_t hstepA = (size_t)HALF * g.lda * 2, hstepB = (size_t)HALF * g.ldb * 2;
    const unsigned ldsw = (unsigned)wid * 1024u;
    const int aoff = lds_byte(wr * 64 + fr, fq * 8), boff = lds_byte(wc * 32 + fr, fq * 8);
#define PG8_SA(b, h) (((b) * 2 + (h)) * HTB)
#define PG8_SB(b, h) ((4 + (b) * 2 + (h)) * HTB)
#define PG8_STAGE(bufoff, gbase, voff) do { const __attribute__((address_space(1))) char* _gb = (const __attribute__((address_space(1))) char*)(gbase); asm volatile("" : "+s"(_gb));     \
        _Pragma("unroll") for (int _i = 0; _i < 2; ++_i) \
        __builtin_amdgcn_global_load_lds((const __attribute__((address_space(1))) unsigned*)(_gb + (voff)[_i]), (LAS unsigned*)(lds + (bufoff) + ldsw + _i * 8192), 16, 0, 0); } while (0)
#define PG8_LDA(dst, b, h) do { _Pragma("unroll") for (int m = 0; m < 4; ++m) _Pragma("unroll") for (int k = 0; k < 2; ++k) dst[m][k] = *(const LAS bf16x8*)(lds + PG8_SA(b, h) + aoff + m * 2048 + k * 1024); } while (0)
#define PG8_LDB(dst, b, h) do { _Pragma("unroll") for (int n = 0; n < 2; ++n) _Pragma("unroll") for (int k = 0; k < 2; ++k) dst[n][k] = *(const LAS bf16x8*)(lds + PG8_SB(b, h) + boff + n * 2048 + k * 1024); } while (0)
#define PG8_MMA(ai, bj, At, Bt) do { __builtin_amdgcn_s_setprio(1); _Pragma("unroll") for (int m = 0; m < 4; ++m) _Pragma("unroll") for (int n = 0; n < 2; ++n) _Pragma("unroll") for (int k = 0; k < 2; ++k) \
        acc[ai][bj][m][n] = __builtin_amdgcn_mfma_f32_16x16x32_bf16(Bt[n][k], At[m][k], acc[ai][bj][m][n], 0, 0, 0); __builtin_amdgcn_s_setprio(0); } while (0)
#define PG8_WAIT_V(n) asm volatile("s_waitcnt vmcnt(" #n ")" ::: "memory")
#define PG8_WAIT_L(n) asm volatile("s_waitcnt lgkmcnt(" #n ")" ::: "memory")
#define PG8_BAR __builtin_amdgcn_s_barrier()
#define PG8_SCHED __builtin_amdgcn_sched_barrier(0)
    Unit cur, nxt; int ui = 0;
    if (!S.next(0, cur)) return;
    f32x4 acc[2][2][4][2];
#pragma unroll
    for (int a = 0; a < 2; ++a)
#pragma unroll
        for (int b = 0; b < 2; ++b)
#pragma unroll
            for (int m = 0; m < 4; ++m)
#pragma unroll
                for (int n = 0; n < 2; ++n) acc[a][b][m][n] = (f32x4){0.f, 0.f, 0.f, 0.f};
    bf16x8 At[4][2], B0[2][2], B1[2][2];
    const char* cA = cur.a; const char* cB = cur.b;
    if constexpr (SP2) {
        PG8_STAGE(PG8_SB(0, 0), cB, voffB); PG8_STAGE(PG8_SB(0, 1), cB + hstepB, voffB); PG8_STAGE(PG8_SA(0, 0), cA, voffA); PG8_STAGE(PG8_SA(0, 1), cA + hstepA, voffA);
        if (wr == 1) PG8_BAR;
        PG8_WAIT_V(2); PG8_BAR;
        PG8_STAGE(PG8_SB(1, 0), cB + kstep, voffB); PG8_STAGE(PG8_SA(1, 0), cA + kstep, voffA); PG8_STAGE(PG8_SB(1, 1), cB + hstepB + kstep, voffB);
        PG8_WAIT_V(6); PG8_BAR;
    } else {
    PG8_STAGE(PG8_SB(0, 0), cB, voffB); PG8_STAGE(PG8_SA(0, 0), cA, voffA); PG8_STAGE(PG8_SB(0, 1), cB + hstepB, voffB); PG8_STAGE(PG8_SA(0, 1), cA + hstepA, voffA);
    if (wr == 1) PG8_BAR;
    PG8_WAIT_V(4); PG8_BAR;
    PG8_STAGE(PG8_SB(1, 0), cB + kstep, voffB); PG8_STAGE(PG8_SA(1, 0), cA + kstep, voffA); PG8_STAGE(PG8_SB(1, 1), cB + hstepB + kstep, voffB);
    PG8_WAIT_V(6); PG8_BAR;
    }
    for (;;) {
        const bool has_next = S.next(ui + 1, nxt);
        const char* nA = has_next ? nxt.a : cA; const char* nB = has_next ? nxt.b : cB;
        for (int t = 0; t < nt; t += 2) {
            const bool last = (t == nt - 2);
            const char* a1 = cA + (size_t)(t + 1) * kstep;
            const char* a2 = last ? nA : cA + (size_t)(t + 2) * kstep; const char* b2 = last ? nB : cB + (size_t)(t + 2) * kstep;
            const char* a3 = a2 + kstep; const char* b3 = b2 + kstep;
            if constexpr (SP2) {
            PG8_LDB(B0, 0, 0); PG8_LDB(B1, 0, 1); PG8_SCHED; PG8_LDA(At, 0, 0); PG8_STAGE(PG8_SA(1, 1), a1 + hstepA, voffA);
            PG8_WAIT_V(8); PG8_WAIT_L(0); PG8_BAR; PG8_MMA(0, 0, At, B0); PG8_MMA(0, 1, At, B1); PG8_BAR; PG8_SCHED;
            PG8_LDA(At, 0, 1); PG8_STAGE(PG8_SB(0, 0), b2, voffB); PG8_STAGE(PG8_SB(0, 1), b2 + hstepB, voffB); PG8_STAGE(PG8_SA(0, 0), a2, voffA);
            PG8_WAIT_V(8); PG8_WAIT_L(0); PG8_BAR; PG8_MMA(1, 0, At, B0); PG8_MMA(1, 1, At, B1); PG8_BAR; PG8_SCHED;
            PG8_LDB(B0, 1, 0); PG8_LDB(B1, 1, 1); PG8_SCHED; PG8_LDA(At, 1, 0); PG8_STAGE(PG8_SA(0, 1), a2 + hstepA, voffA);
            PG8_WAIT_V(8); PG8_WAIT_L(0); PG8_BAR; PG8_MMA(0, 0, At, B0); PG8_MMA(0, 1, At, B1); PG8_BAR; PG8_SCHED;
            PG8_LDA(At, 1, 1); PG8_STAGE(PG8_SB(1, 0), b3, voffB); PG8_STAGE(PG8_SB(1, 1), b3 + hstepB, voffB); PG8_STAGE(PG8_SA(1, 0), a3, voffA);
            PG8_WAIT_V(8); PG8_WAIT_L(0); PG8_BAR; PG8_MMA(1, 0, At, B0); PG8_MMA(1, 1, At, B1); PG8_BAR; PG8_SCHED;
            } else {
            PG8_LDB(B0, 0, 0); PG8_SCHED; PG8_LDA(At, 0, 0); PG8_STAGE(PG8_SA(1, 1), a1 + hstepA, voffA);
            PG8_WAIT_L(8); PG8_BAR; PG8_WAIT_L(0); PG8_MMA(0, 0, At, B0); PG8_BAR; PG8_SCHED;
            PG8_LDB(B1, 0, 1); PG8_STAGE(PG8_SB(0, 0), b2, voffB);
            PG8_BAR; PG8_WAIT_L(0); PG8_MMA(0, 1, At, B1); PG8_BAR;
            PG8_LDA(At, 0, 1); PG8_STAGE(PG8_SA(0, 0), a2, voffA);
            PG8_BAR; PG8_WAIT_L(0); PG8_MMA(1, 0, At, B0); PG8_BAR; PG8_SCHED;
            PG8_STAGE(PG8_SB(0, 1), b2 + hstepB, voffB);
            PG8_WAIT_V(6); PG8_BAR; PG8_MMA(1, 1, At, B1); PG8_BAR;
            PG8_LDB(B0, 1, 0); PG8_SCHED; PG8_LDA(At, 1, 0); PG8_STAGE(PG8_SA(0, 1), a2 + hstepA, voffA);
            PG8_WAIT_L(8); PG8_BAR; PG8_WAIT_L(0); PG8_MMA(0, 0, At, B0); PG8_BAR; PG8_SCHED;
            PG8_LDB(B1, 1, 1); PG8_STAGE(PG8_SB(1, 0), b3, voffB);
            PG8_BAR; PG8_WAIT_L(0); PG8_MMA(0, 1, At, B1); PG8_BAR;
            PG8_LDA(At, 1, 1); PG8_STAGE(PG8_SA(1, 0), a3, voffA);
            PG8_BAR; PG8_WAIT_L(0); PG8_MMA(1, 0, At, B0); PG8_BAR; PG8_SCHED;
            PG8_STAGE(PG8_SB(1, 1), b3 + hstepB, voffB);
            PG8_WAIT_V(6); PG8_BAR; PG8_MMA(1, 1, At, B1); PG8_BAR;
            }
        }
        if constexpr (ALIGN_EPI) { if (wr == 0) PG8_BAR; }
        E(acc, cur, wr, wc, fr, fq);
        if (!has_next) break;
#pragma unroll
        for (int a = 0; a < 2; ++a)
#pragma unroll
            for (int b = 0; b < 2; ++b)
#pragma unroll
                for (int m = 0; m < 4; ++m)
#pragma unroll
                    for (int n = 0; n < 2; ++n) acc[a][b][m][n] = (f32x4){0.f, 0.f, 0.f, 0.f};
        cur = nxt; cA = nA; cB = nB; ++ui;
        if constexpr (ALIGN_EPI) { if (wr == 1) PG8_BAR; }
    }
    PG8_WAIT_V(0);
    if constexpr (!ALIGN_EPI) { if (wr == 0) PG8_BAR; }
    PG8_BAR;
#undef PG8_SA
#undef PG8_SB
#undef PG8_STAGE
#undef PG8_LDA
#undef PG8_LDB
#undef PG8_MMA
#undef PG8_WAIT_V
#undef PG8_WAIT_L
#undef PG8_BAR
#undef PG8_SCHED
}

struct EpiCtx { float rs[8]; float cs[16]; };
struct EpiPre { u32x4 a, b, c; };
template <class F> struct Epi {
    F f;
    __device__ __forceinline__ void operator()(const f32x4 (&acc)[2][2][4][2], const Unit& u, int wr, int wc, int, int) const {
        __builtin_amdgcn_sched_barrier(0);
        int ln; asm volatile("v_mbcnt_lo_u32_b32 %0, -1, 0\n\tv_mbcnt_hi_u32_b32 %0, -1, %0" : "=v"(ln));
        const int fr = ln & 15, fq = ln >> 4;
        EpiCtx ctx; f.unit_begin(u, wr, wc, fr, fq, ctx);
        constexpr int GR = F::GROUP_ROWS;
        float ssqs[8];
#pragma unroll
        for (int ai = 0; ai < 2; ++ai)
#pragma unroll
            for (int mg = 0; mg < 4 / GR; ++mg) {
                __builtin_amdgcn_sched_barrier(0);
                EpiPre pre[GR][2];
#pragma unroll
                for (int mm = 0; mm < GR; ++mm)
#pragma unroll
                    for (int bj = 0; bj < 2; ++bj) f.pre(u, ai * HALF + wr * 64 + (GR * mg + mm) * 16 + fr, bj * HALF + wc * 32 + 8 * fq, pre[mm][bj]);
#pragma unroll
                for (int mm = 0; mm < GR; ++mm) {
                    const int m = GR * mg + mm, row = ai * HALF + wr * 64 + m * 16 + fr;
                    float ssq = 0.f;
#pragma unroll
                    for (int bj = 0; bj < 2; ++bj) ssq += f.store(u, row, bj * HALF + wc * 32 + 8 * fq, acc[ai][bj][m][0], acc[ai][bj][m][1], pre[mm][bj], ctx, ai * 4 + m, bj);
                    ssqs[ai * 4 + m] = ssq;
                }
            }
        __builtin_amdgcn_sched_barrier(0);
#pragma unroll
        for (int k = 0; k < 8; ++k) f.row_done(u, (k >> 2) * HALF + wr * 64 + (k & 3) * 16 + fr, ssqs[k], fq * 16 + fr);
    }
};
}
using pg8::Unit;

DEV void st_bf16x8(bf16_t* p, f32x4 v0, f32x4 v1) {
    u32x4 o; o.x = cvt_pk_bf16(v0[0], v0[1]); o.y = cvt_pk_bf16(v0[2], v0[3]); o.z = cvt_pk_bf16(v1[0], v1[1]); o.w = cvt_pk_bf16(v1[2], v1[3]);
    *(u32x4*)p = o;
}
DEV void st_bf16x8g(__attribute__((address_space(1))) bf16_t* p, f32x4 v0, f32x4 v1) {
    u32x4 o; o.x = cvt_pk_bf16(v0[0], v0[1]); o.y = cvt_pk_bf16(v0[2], v0[3]); o.z = cvt_pk_bf16(v1[0], v1[1]); o.w = cvt_pk_bf16(v1[2], v1[3]);
    *(__attribute__((address_space(1))) u32x4*)p = o;
}
DEV void ld_bf16x8(const bf16_t* p, f32x4& v0, f32x4& v1) {
    const u32x4 q = *(const u32x4*)p;
    v0 = (f32x4){bf_lo(q.x), bf_hi(q.x), bf_lo(q.y), bf_hi(q.y)}; v1 = (f32x4){bf_lo(q.z), bf_hi(q.z), bf_lo(q.w), bf_hi(q.w)};
}
DEV f32x4 sig4(f32x4 v) { return (f32x4){sigmoidf_(v[0]), sigmoidf_(v[1]), sigmoidf_(v[2]), sigmoidf_(v[3])}; }

template <class Dec> struct FlatSched {
    Dec d; int total, G, c;
    __device__ __forceinline__ bool next(int i, Unit& u) const { const int idx = i * G + c; if (idx < 0 || idx >= total) return false; d.decode(idx, u); return true; }
};

typedef float cf __attribute__((ext_vector_type(2)));
#define CF(a, b) ((cf){(a), (b)})
DEV cf cadd(cf a, cf b) { return a + b; }
DEV cf csub(cf a, cf b) { return a - b; }
DEV cf cmul(cf a, cf b) { return CF(a.x * b.x - a.y * b.y, a.x * b.y + a.y * b.x); }
template <bool INV> DEV cf twid(float x) { const float c = __builtin_amdgcn_cosf(x), s = __builtin_amdgcn_sinf(x); return CF(c, INV ? s : -s); }
template <bool INV> DEV void twid15(float x, cf (&w)[16]) {
    w[1] = twid<INV>(x); w[2] = cmul(w[1], w[1]); w[4] = cmul(w[2], w[2]); w[8] = cmul(w[4], w[4]);
    w[3] = cmul(w[1], w[2]); w[5] = cmul(w[1], w[4]); w[6] = cmul(w[2], w[4]); w[9] = cmul(w[1], w[8]); w[10] = cmul(w[2], w[8]); w[12] = cmul(w[4], w[8]);
    w[7] = cmul(w[3], w[4]); w[11] = cmul(w[3], w[8]); w[13] = cmul(w[5], w[8]); w[14] = cmul(w[6], w[8]); w[15] = cmul(w[7], w[8]);
}
template <int K, bool INV> DEV cf mulw16(cf a) {
    constexpr float C1 = 0.9238795325112867f, S1 = 0.3826834323650898f, C2 = 0.7071067811865476f;
    if constexpr (K == 0) return a;
    else if constexpr (K == 4) return INV ? CF(-a.y, a.x) : CF(a.y, -a.x);
    else {
        constexpr float wr = (K == 1) ? C1 : (K == 2) ? C2 : (K == 3) ? S1 : (K == 5) ? -S1 : (K == 6) ? -C2 : -C1;
        constexpr float wi0 = (K == 1) ? -S1 : (K == 2) ? -C2 : (K == 3) ? -C1 : (K == 5) ? -C1 : (K == 6) ? -C2 : -S1;
        constexpr float wi = INV ? -wi0 : wi0;
        cf r, t; const cf c = CF(wr, wi);
        asm("v_pk_mul_f32 %1, %2, %3 op_sel_hi:[1,0]\n\ts_nop 0\n\tv_pk_fma_f32 %0, %2, %3, %1 op_sel:[1,1,0] op_sel_hi:[0,1,1] neg_lo:[1,0,0]\n\ts_nop 0"
            : "=&v"(r), "=&v"(t) : "v"(a), "s"(c));
        return r;
    }
}
template <int S, int I, bool INV> DEV void bfly(cf& a, cf& b) { const cf t = csub(a, b); a = cadd(a, b); b = mulw16<I * (8 / S), INV>(t); }
template <bool INV> DEV void dft16(cf (&x)[16]) {
    bfly<8, 0, INV>(x[0], x[8]);  bfly<8, 1, INV>(x[1], x[9]);  bfly<8, 2, INV>(x[2], x[10]); bfly<8, 3, INV>(x[3], x[11]);
    bfly<8, 4, INV>(x[4], x[12]); bfly<8, 5, INV>(x[5], x[13]); bfly<8, 6, INV>(x[6], x[14]); bfly<8, 7, INV>(x[7], x[15]);
#define BF4(o) bfly<4, 0, INV>(x[o + 0], x[o + 4]); bfly<4, 1, INV>(x[o + 1], x[o + 5]); bfly<4, 2, INV>(x[o + 2], x[o + 6]); bfly<4, 3, INV>(x[o + 3], x[o + 7]);
    BF4(0) BF4(8)
#undef BF4
#define BF2(o) bfly<2, 0, INV>(x[o + 0], x[o + 2]); bfly<2, 1, INV>(x[o + 1], x[o + 3]);
    BF2(0) BF2(4) BF2(8) BF2(12)
#undef BF2
#define BF1(o) bfly<1, 0, INV>(x[o], x[o + 1]);
    BF1(0) BF1(2) BF1(4) BF1(6) BF1(8) BF1(10) BF1(12) BF1(14)
#undef BF1
    cf t;
    t = x[1]; x[1] = x[8]; x[8] = t;   t = x[2]; x[2] = x[4]; x[4] = t;   t = x[3]; x[3] = x[12]; x[12] = t;
    t = x[5]; x[5] = x[10]; x[10] = t; t = x[7]; x[7] = x[14]; x[14] = t; t = x[11]; x[11] = x[13]; x[13] = t;
}
constexpr int FFT_BUF_ELEMS = 4352;
typedef LAS cf* lcf;
DEV void fft_s1f(cf (&x)[16], lcf buf, int r) {
    asm volatile("" : "+v"(r));
    dft16<false>(x);
    const int base = 17 * (r >> 4) + (r & 15);
    float fr = (float)r * (1.0f / 4096.0f); asm volatile("" : "+v"(fr));
    buf[base] = x[0];
    cf w[16]; twid15<false>(fr, w);
#pragma unroll
    for (int b = 1; b < 16; ++b) buf[272 * b + base] = cmul(x[b], w[b]);
}
DEV void fft_s2f(lcf buf, int r) {
    asm volatile("" : "+v"(r));
    const int b = r >> 4, rp = r & 15; cf x[16];
#pragma unroll
    for (int a = 0; a < 16; ++a) x[a] = buf[272 * b + 17 * a + rp];
    dft16<false>(x);
    float fr = (float)rp * (1.0f / 256.0f); asm volatile("" : "+v"(fr));
    cf w[16]; twid15<false>(fr, w);
#pragma unroll
    for (int q = 0; q < 16; ++q) buf[272 * b + 17 * q + rp] = (q == 0) ? x[0] : cmul(x[q], w[q]);
}
DEV void fft_s3f(cf (&x)[16], lcf buf, int r) {
    asm volatile("" : "+v"(r));
    const int b = r >> 4, bp = r & 15;
#pragma unroll
    for (int a = 0; a < 16; ++a) x[a] = buf[272 * b + 17 * bp + a];
    dft16<false>(x);
}
DEV void fft_s3i(cf (&x)[16], lcf buf, int r) {
    asm volatile("" : "+v"(r));
    const int b = r >> 4, bp = r & 15;
    dft16<true>(x);
#pragma unroll
    for (int a = 0; a < 16; ++a) buf[272 * b + 17 * bp + a] = x[a];
}
DEV void fft_s2i(lcf buf, int r) {
    asm volatile("" : "+v"(r));
    const int b = r >> 4, rp = r & 15; cf x[16];
    float fr = (float)rp * (1.0f / 256.0f); asm volatile("" : "+v"(fr));
    cf w[16]; twid15<true>(fr, w);
#pragma unroll
    for (int q = 0; q < 16; ++q) { const cf v = buf[272 * b + 17 * q + rp]; x[q] = (q == 0) ? v : cmul(v, w[q]); }
    dft16<true>(x);
#pragma unroll
    for (int a = 0; a < 16; ++a) buf[272 * b + 17 * a + rp] = x[a];
}
DEV void fft_s1i(cf (&x)[16], lcf buf, int r) {
    asm volatile("" : "+v"(r));
    const int base = 17 * (r >> 4) + (r & 15);
    float fr = (float)r * (1.0f / 4096.0f); asm volatile("" : "+v"(fr));
    x[0] = buf[base];
    cf w[16]; twid15<true>(fr, w);
#pragma unroll
    for (int b = 1; b < 16; ++b) x[b] = cmul(buf[272 * b + base], w[b]);
    dft16<true>(x);
}

#define XB_TMO      128
#define XB_XCNT(j)  (256  + 64 * (j))
#define XB_XSUB(j)  (1280 + 64 * (j))
#define XB_XGEN(j)  (2304 + 64 * (j))
#define XB_TOP      3328
#define XB_TOPGEN   3392
#define XCD_BAR_WORDS 3456
#define XB_SPIN_CAP (1u << 22)
DEV unsigned xb_ld(unsigned* p)              { return __hip_atomic_load(p, __ATOMIC_RELAXED, __HIP_MEMORY_SCOPE_AGENT); }
DEV unsigned xb_add(unsigned* p, unsigned v) { return __hip_atomic_fetch_add(p, v, __ATOMIC_RELAXED, __HIP_MEMORY_SCOPE_AGENT); }
DEV unsigned xb_xcc_id() { return (unsigned)__builtin_amdgcn_s_getreg((3 << 11) | 20) & 0xFu; }
#define XB_SPIN(cond, bar) do { unsigned _sp = 0; while (cond) { __builtin_amdgcn_s_sleep(1); \
    if ((++_sp & 255u) == 0u) { if (xb_ld(&(bar)[XB_TMO])) break; if (_sp > XB_SPIN_CAP) { atomicAdd(&(bar)[XB_TMO], 1u); break; } } } } while (0)
struct XcdBarrier { unsigned* bar; unsigned x; volatile LAS unsigned* st; };
DEV XcdBarrier xcd_barrier_post(unsigned* bar, volatile LAS unsigned* st) {
    XcdBarrier b; b.bar = bar; b.x = (unsigned)__builtin_amdgcn_readfirstlane((int)xb_xcc_id()); b.st = st;
    if (threadIdx.x == 0) (void)xb_add(&bar[XB_XCNT(b.x)], 1u);
    return b;
}
DEV void xcd_barrier_complete(unsigned* bar, unsigned x, unsigned& nloc, unsigned& nx) {
    const unsigned G = gridDim.x * gridDim.y * gridDim.z;
    unsigned sum, cnt, mine, sp = 0u;
    for (;;) {
        sum = 0u; cnt = 0u; mine = 0u;
#pragma unroll 1
        for (unsigned j = 0; j < 16; ++j) { const unsigned c = xb_ld(&bar[XB_XCNT(j)]); sum += c; cnt += (c > 0u) ? 1u : 0u; mine = (j == x) ? c : mine; }
        if (sum == G) break;
        __builtin_amdgcn_s_sleep(1);
        if ((++sp & 255u) == 0u) { if (xb_ld(&bar[XB_TMO])) break; if (sp > XB_SPIN_CAP) { atomicAdd(&bar[XB_TMO], 1u); break; } }
    }
    nloc = mine > 0u ? mine : 1u; nx = cnt > 0u ? cnt : 1u;
}
DEV void xcd_barrier(const XcdBarrier& b) {
    asm volatile("s_waitcnt vmcnt(0)" ::: "memory");
    __syncthreads();
    if (threadIdx.x == 0) {
        unsigned* bar = b.bar;
        const unsigned bx = (unsigned)__builtin_amdgcn_readfirstlane((int)xb_xcc_id());
        __builtin_amdgcn_s_waitcnt(0);
        unsigned nloc = b.st[0], nx = b.st[1];
        if (nloc == 0u) { xcd_barrier_complete(bar, bx, nloc, nx); b.st[0] = nloc; b.st[1] = nx; }
        const unsigned old = xb_add(&bar[XB_XSUB(bx)], 1u);
        const unsigned gen = old / nloc;
        if (old + 1u == (gen + 1u) * nloc) {
            __builtin_amdgcn_fence(__ATOMIC_RELEASE, "agent");
            asm volatile("s_waitcnt vmcnt(0)" ::: "memory");
            const unsigned og = xb_add(&bar[XB_TOP], 1u);
            const unsigned tg = og / nx;
            if (og + 1u == (tg + 1u) * nx) xb_add(&bar[XB_TOPGEN], 1u);
            else XB_SPIN(xb_ld(&bar[XB_TOPGEN]) == tg, bar);
            __builtin_amdgcn_fence(__ATOMIC_ACQUIRE, "agent");
            xb_add(&bar[XB_XGEN(bx)], 1u);
            asm volatile("s_waitcnt vmcnt(0)" ::: "memory");
        } else {
            XB_SPIN(xb_ld(&bar[XB_XGEN(bx)]) == gen, bar);
            __builtin_amdgcn_fence(__ATOMIC_ACQUIRE, "agent");
            asm volatile("s_waitcnt vmcnt(0)" ::: "memory");
        }
    }
    __syncthreads();
}

struct Frame {
    LAS unsigned char* lds;
    int tid, lane, wave, c, G;
    const __attribute__((address_space(4))) Params* P;
    float* out; unsigned char* ws;
};
#define WSP(T, off) ((T*)(F.ws + (off)))

DEV void transpose_item(const Frame& F, const float* src, int ldn, bf16_t* dst, int ldk, int k0, int n0, const float* kscale = nullptr) {
    LAS float* tile = (LAS float*)F.lds;
    const int row = F.tid >> 3, c8 = (F.tid & 7) * 8;
    const float ks = kscale ? kscale[k0 + row] : 1.0f;
    f32x4 a[4], b[4];
#pragma unroll
    for (int q = 0; q < 4; ++q) { const float* sp = src + (size_t)(k0 + row) * ldn + n0 + 64 * q + c8; a[q] = (*((const f32x4*)sp)); b[q] = (*((const f32x4*)(sp + 4))); }
#pragma unroll
    for (int q = 0; q < 4; ++q) { LAS float* tp = tile + q * (64 * 65) + row * 65 + c8; const f32x4 x = a[q] * ks, y = b[q] * ks;
        tp[0] = x[0]; tp[1] = x[1]; tp[2] = x[2]; tp[3] = x[3]; tp[4] = y[0]; tp[5] = y[1]; tp[6] = y[2]; tp[7] = y[3]; }
    __syncthreads();
#pragma unroll
    for (int q = 0; q < 4; ++q) { const int n = row; const LAS float* sq = tile + q * (64 * 65) + c8 * 65 + n;
        u32x4 o; o.x = cvt_pk_bf16(sq[0], sq[65]); o.y = cvt_pk_bf16(sq[2 * 65], sq[3 * 65]); o.z = cvt_pk_bf16(sq[4 * 65], sq[5 * 65]); o.w = cvt_pk_bf16(sq[6 * 65], sq[7 * 65]);
        *(u32x4*)(dst + (size_t)(n0 + 64 * q + n) * ldk + k0 + c8) = o; }
    __syncthreads();
}
DEV void p0_transposes(const Frame& F) {
    constexpr int N_WIN = 32 * 32, N_WPO = 128, N_WHO = 128, N_WO = 256, N_WG = 256, N_WP = 32;
    constexpr int PER_LAYER = N_WIN + N_WPO + N_WHO + N_WO + N_WG + N_WP;
    for (int it = F.c; it < 2 * PER_LAYER; it += F.G) {
        const int l = it / PER_LAYER; int r = it % PER_LAYER;
        if (r < N_WIN) { transpose_item(F, F.P->in[3] + (size_t)l * D_ * INC_, INC_, WSP(bf16_t, WS_WIN_T) + (size_t)l * INC_ * D_, D_, (r / 32) * 64, (r % 32) * 256, F.P->in[2] + (size_t)l * D_); continue; } r -= N_WIN;
        if (r < N_WPO) { transpose_item(F, F.P->in[6] + (size_t)l * PW_ * D_, D_, WSP(bf16_t, WS_WPO_T) + (size_t)l * D_ * PW_, PW_, (r / 8) * 64, (r % 8) * 256, F.P->in[5] + (size_t)l * PW_); continue; } r -= N_WPO;
        if (r < N_WHO) { transpose_item(F, F.P->in[16] + (size_t)l * HW_ * D_, D_, WSP(bf16_t, WS_WHO_T) + (size_t)l * D_ * HW_, HW_, (r / 8) * 64, (r % 8) * 256); continue; } r -= N_WHO;
        if (r < N_WO) { transpose_item(F, F.P->in[17] + (size_t)l * D_ * D_, D_, WSP(bf16_t, WS_WO_T) + (size_t)l * D_ * D_, D_, (r / 8) * 64, (r % 8) * 256); continue; } r -= N_WO;
        if (r < N_WG) { transpose_item(F, F.P->in[25] + (size_t)l * D_ * D_, D_, WSP(bf16_t, WS_WG_T) + (size_t)l * D_ * D_, D_, (r / 8) * 64, (r % 8) * 256, F.P->in[24] + (size_t)l * D_); continue; } r -= N_WG;
        transpose_item(F, F.P->in[26] + (size_t)l * PLE_ * D_, D_, WSP(bf16_t, WS_WP_T) + (size_t)l * D_ * PLE_, PLE_, (r / 8) * 64, (r % 8) * 256);
    }
}
DEV void convert_bf16(const Frame& F, const float* src, bf16_t* dst, size_t n) {
    const size_t n8 = n / 8;
    for (size_t i = (size_t)F.c * NTHREADS + F.tid; i < n8; i += (size_t)F.G * NTHREADS) {
        const f32x4 a = (*((const f32x4*)src + 2 * i)), b = (*((const f32x4*)src + 2 * i + 1));
        u32x4 o; o.x = cvt_pk_bf16(a[0], a[1]); o.y = cvt_pk_bf16(a[2], a[3]); o.z = cvt_pk_bf16(b[0], b[1]); o.w = cvt_pk_bf16(b[2], b[3]);
        *((u32x4*)dst + i) = o;
    }
}
typedef float f32x2 __attribute__((ext_vector_type(2)));
constexpr float PEER_U_SCALE = 256.0f, PEER_V_SCALE = 16.0f;
constexpr size_t PEER_SLS = (size_t)NEXP_ * 128 + 33 * 256;
constexpr size_t PEER_TBL = 48 * MiB;
DEV unsigned pk4_fp8(f32x4 a, float sc) { int w = __builtin_amdgcn_cvt_pk_fp8_f32(a[0] * sc, a[1] * sc, 0, false); w = __builtin_amdgcn_cvt_pk_fp8_f32(a[2] * sc, a[3] * sc, w, true); return (unsigned)w; }
DEV void convert_sliced(const Frame& F, const float* src, unsigned char* dst, float sc, const float* dscale) {
    const size_t n16 = (size_t)NEXP_ * D_ / 16, stride = (size_t)F.G * NTHREADS;
    for (size_t i0 = (size_t)F.c * NTHREADS + F.tid; i0 < n16; i0 += 2 * stride) {
        f32x4 v[2][4];
#pragma unroll
        for (int u = 0; u < 2; ++u) { const f32x4* sp = (const f32x4*)src + 4 * (i0 + u * stride);
#pragma unroll
            for (int q = 0; q < 4; ++q) v[u][q] = sp[q]; }
#pragma unroll
        for (int u = 0; u < 2; ++u) { const size_t i = i0 + u * stride;
            if (dscale) { const f32x4* gp = (const f32x4*)dscale + 4 * (i & 127);
#pragma unroll
                for (int q = 0; q < 4; ++q) v[u][q] *= gp[q]; }
            u32x4 o; o.x = pk4_fp8(v[u][0], sc); o.y = pk4_fp8(v[u][1], sc); o.z = pk4_fp8(v[u][2], sc); o.w = pk4_fp8(v[u][3], sc);
            const size_t e = i >> 7, cc = i & 127, sl = cc >> 3, j8 = cc & 7;
            *(u32x4*)(dst + (sl * PEER_SLS + e * 128 + j8 * 16)) = o; }
    }
}
DEV void convert_rows(const Frame& F, const float* src, bf16_t* dst, int R, int C, const float* rowscale) {
    const int c8n = C / 8;
    for (int i = F.c * NTHREADS + F.tid; i < R * c8n; i += F.G * NTHREADS) {
        const float rs = rowscale ? rowscale[i / c8n] : 1.0f;
        const f32x4 a = (*((const f32x4*)src + 2 * (size_t)i)) * rs, b = (*((const f32x4*)src + 2 * (size_t)i + 1)) * rs;
        u32x4 o; o.x = cvt_pk_bf16(a[0], a[1]); o.y = cvt_pk_bf16(a[2], a[3]); o.z = cvt_pk_bf16(b[0], b[1]); o.w = cvt_pk_bf16(b[2], b[3]);
        *((u32x4*)dst + i) = o;
    }
}
DEV void p0_small(const Frame& F) {
    for (int i = F.c * NTHREADS + F.tid; i < 2 * 65536; i += F.G * NTHREADS) {
        const int l = i >> 16, n = (i >> 8) & 255, k = i & 255; float v = 0.f;
        if (n < 128 && k < 128) v = F.P->in[20][(size_t)l * 16384 + n * 128 + k];
        else if (n >= 128 && k >= 128) v = F.P->in[21][(size_t)l * 16384 + (n - 128) * 128 + (k - 128)];
        WSP(bf16_t, WS_KBD)[i] = f2bf(v);
    }
    for (int i = F.c * NTHREADS + F.tid; i < 2 * 4096 * 64; i += F.G * NTHREADS) {
        const int l = i / (4096 * 64), r = i % (4096 * 64), j = r / 4096, col = r % 4096;
        const float w = F.P->in[13][(size_t)l * 64 * 4096 + (size_t)j * 4096 + col];
        const bf16_t hi = f2bf(w), lo = f2bf(w - bf1(hi));
        bf16_t* o = WSP(bf16_t, WS_W3A) + ((size_t)l * 4096 + col) * 256;
        o[j] = hi; o[64 + j] = hi; o[128 + j] = lo; o[192 + j] = 0;
    }
}
DEV void p0_hdn(const Frame& F) {
    LAS float* zf = (LAS float*)F.lds;
    LAS float* h1 = zf + 8 * 40;
    const int li = F.tid >> 6, j = F.tid & 63;
    for (int blk = F.c; blk < 2 * 256; blk += F.G) {
        const int l = blk >> 8, pos = (blk & 255) * 8 + li;
        const float* w1 = F.P->in[9] + (size_t)l * 33 * 64; const float* b1 = F.P->in[10] + l * 64; const float* w2 = F.P->in[11] + (size_t)l * 64 * 64;
        const float* b2 = F.P->in[12] + l * 64; const float* fq = F.P->in[14] + l * 64;
        if (j < 33) {
            float v;
            if (j == 0) v = (float)pos / (float)(L_ - 1);
            else { const int k = (j - 1) & 15; const double fb = 1e-4 + (double)k * ((15.0 - 1e-4) / 15.0); const double ang = (2.0 * 3.14159265358979323846 / (double)L_) * (double)pos * fb;
                v = (j <= 16) ? (float)cos(ang) : (float)(-sin(ang)); }
            zf[li * 40 + j] = v;
        }
        __syncthreads();
        float s = b1[j];
        for (int i = 0; i < 33; ++i) s += zf[li * 40 + i] * w1[i * 64 + j];
        h1[li * 64 + j] = sinf(fq[j] * s);
        __syncthreads();
        float s2 = b2[j];
        for (int i = 0; i < 64; ++i) s2 += h1[li * 64 + i] * w2[i * 64 + j];
        const float hv = sinf(fq[j] * s2);
        const bf16_t hi = f2bf(hv), lo = f2bf(hv - bf1(hi));
        bf16_t* o = WSP(bf16_t, WS_HB) + ((size_t)l * 2048 + pos) * 256;
        o[j] = hi; o[64 + j] = lo; o[128 + j] = hi; o[192 + j] = 0;
        __syncthreads();
    }
}

DEV void phase_final_norm(const Frame& F, const bf16_t* h, const float* g, float* outp) {
    for (int row = F.c * NWAVES + F.wave; row < T_; row += F.G * NWAVES) {
        const u32x4* hr = (const u32x4*)(h + (size_t)row * D_) + F.lane;
        f32x4 v[8]; float ss = 0.f;
#pragma unroll
        for (int j = 0; j < 4; ++j) { const u32x4 q = hr[64 * j]; v[2 * j] = (f32x4){bf_lo(q.x), bf_hi(q.x), bf_lo(q.y), bf_hi(q.y)}; v[2 * j + 1] = (f32x4){bf_lo(q.z), bf_hi(q.z), bf_lo(q.w), bf_hi(q.w)};
            ss += ssq8(v[2 * j], v[2 * j + 1]); }
        ss = wave_sum(ss);
        const float r = 1.0f / sqrtf(ss * (1.0f / D_) + EPS_);
#pragma unroll
        for (int j = 0; j < 4; ++j) { const f32x4* gr = (const f32x4*)(g + 512 * j + 8 * F.lane); float* op = outp + (size_t)row * D_ + 512 * j + 8 * F.lane;
            *(f32x4*)op = v[2 * j] * r * gr[0]; *(f32x4*)(op + 4) = v[2 * j + 1] * r * gr[1]; }
    }
}
template <bool F32OUT> DEV void phase_rmsnorm(const Frame& F, const float* h, const float* g, void* outp) {
    for (int row = F.c * NWAVES + F.wave; row < T_; row += F.G * NWAVES) {
        const f32x4* hr = (const f32x4*)(h + (size_t)row * D_) + F.lane;
        f32x4 v[8]; float ss = 0.f;
#pragma unroll
        for (int j = 0; j < 8; ++j) { v[j] = hr[64 * j]; ss += v[j][0] * v[j][0] + v[j][1] * v[j][1] + v[j][2] * v[j][2] + v[j][3] * v[j][3]; }
        ss = wave_sum(ss);
        const float r = 1.0f / sqrtf(ss * (1.0f / D_) + EPS_);
        const f32x4* gr = (const f32x4*)g + F.lane;
#pragma unroll
        for (int j = 0; j < 8; ++j) {
            const f32x4 gg = gr[64 * j]; const f32x4 o = (f32x4){v[j][0] * r * gg[0], v[j][1] * r * gg[1], v[j][2] * r * gg[2], v[j][3] * r * gg[3]};
            if (F32OUT) *((f32x4*)((float*)outp + (size_t)row * D_) + F.lane + 64 * j) = o;
            else { u32x2 q; q.x = cvt_pk_bf16(o[0], o[1]); q.y = cvt_pk_bf16(o[2], o[3]); *((u32x2*)((bf16_t*)outp + (size_t)row * D_) + F.lane + 64 * j) = q; }
        }
    }
}

DEV void phase_rowstat(const Frame& F, const float* h, bf16_t* hb, ss_t* ss) {
    for (int i = F.c * NTHREADS + F.tid; i < 6 * T_; i += F.G * NTHREADS) ss[T_ + i] = 0ull;
    for (int row = F.c * NWAVES + F.wave; row < T_; row += F.G * NWAVES) {
        const f32x4* hr = (const f32x4*)(h + (size_t)row * D_) + F.lane;
        float s2 = 0.f;
#pragma unroll
        for (int j = 0; j < 8; ++j) { const f32x4 v = hr[64 * j]; s2 += v[0] * v[0] + v[1] * v[1] + v[2] * v[2] + v[3] * v[3];
            u32x2 q; q.x = cvt_pk_bf16(v[0], v[1]); q.y = cvt_pk_bf16(v[2], v[3]); *((u32x2*)(hb + (size_t)row * D_) + F.lane + 64 * j) = q; }
        s2 = wave_sum(s2);
        if (F.lane == 0) ss[row] = ss_fix(s2);
    }
}

DEV void pooldiff_item(const bf16_t* pin, int i, f32x4& o0, f32x4& o1) {
    const int t = i >> 7, c8 = (i & 127) * 8, grp = c8 >> 8, win = 2 << grp, l = t & (L_ - 1), t0 = t - l;
    const int lo = max(l - win / 2, 0), hi = min(l + win - win / 2 - 1, L_ - 1);
    float s[8] = {0.f, 0.f, 0.f, 0.f, 0.f, 0.f, 0.f, 0.f};
    for (int q = lo; q <= hi; ++q) { f32x4 a, b; ld_bf16x8(pin + (size_t)(t0 + q) * PW_ + c8, a, b); s[0] += a[0]; s[1] += a[1]; s[2] += a[2]; s[3] += a[3]; s[4] += b[0]; s[5] += b[1]; s[6] += b[2]; s[7] += b[3]; }
    f32x4 ua, ub; ld_bf16x8(pin + (size_t)t * PW_ + c8, ua, ub);
    const float inv = 1.0f / (float)(hi - lo + 1);
    o0 = (f32x4){s[0] * inv - ua[0], s[1] * inv - ua[1], s[2] * inv - ua[2], s[3] * inv - ua[3]}; o1 = (f32x4){s[4] * inv - ub[0], s[5] * inv - ub[1], s[6] * inv - ub[2], s[7] * inv - ub[3]};
}
DEV void phase_pooldiff(const Frame& F) {
    const bf16_t* pin = WSP(bf16_t, WS_POOLIN); bf16_t* pd = WSP(bf16_t, WS_PD);
    const int stride = F.G * NTHREADS;
    for (int i = F.c * NTHREADS + F.tid; i < T_ * 128; i += 2 * stride) {
        f32x4 a0, a1, b0, b1; pooldiff_item(pin, i, a0, a1); pooldiff_item(pin, i + stride, b0, b1);
        st_bf16x8(pd + (size_t)(i >> 7) * PW_ + (i & 127) * 8, a0, a1); st_bf16x8(pd + (size_t)((i + stride) >> 7) * PW_ + ((i + stride) & 127) * 8, b0, b1);
    }
}

DEV void phase_z2_transpose(const Frame& F) {
    LAS bf16_t* tile = (LAS bf16_t*)F.lds;
    const bf16_t* src = WSP(bf16_t, WS_Z2T); bf16_t* dst = WSP(bf16_t, WS_Z2);
    const int row = F.tid >> 3, c8 = (F.tid & 7) * 8;
    for (int it = F.c; it < 16 * 32; it += F.G) {
        const int ch0 = (it >> 5) * 64, t0 = (it & 31) * 256;
        u32x4 q[4];
#pragma unroll
        for (int k = 0; k < 4; ++k) q[k] = *(const u32x4*)(src + (size_t)(ch0 + row) * T_ + t0 + 64 * k + c8);
#pragma unroll
        for (int k = 0; k < 4; ++k) { LAS unsigned* tp = (LAS unsigned*)(tile + k * (64 * 72) + row * 72 + c8); tp[0] = q[k].x; tp[1] = q[k].y; tp[2] = q[k].z; tp[3] = q[k].w; }
        __syncthreads();
#pragma unroll
        for (int k = 0; k < 4; ++k) { const LAS bf16_t* sq = tile + k * (64 * 72) + c8 * 72 + row;
            u32x4 o;
            o.x = (unsigned)sq[0] | ((unsigned)sq[72] << 16); o.y = (unsigned)sq[2 * 72] | ((unsigned)sq[3 * 72] << 16);
            o.z = (unsigned)sq[4 * 72] | ((unsigned)sq[5 * 72] << 16); o.w = (unsigned)sq[6 * 72] | ((unsigned)sq[7 * 72] << 16);
            *(u32x4*)(dst + (size_t)(t0 + 64 * k + row) * HW_ + ch0 + c8) = o; }
        __syncthreads();
    }
}

#define GAS_ __attribute__((address_space(1)))
struct SideSt { const GAS_ char* isrc; GAS_ unsigned char* idst; GAS_ unsigned char* dcur; f32x4 g0, g1, pa, pb; };
DEV const GAS_ char* side_src(const Frame& F, int layer, int ch) {
    return (const GAS_ char*)(F.P->in[22 + (ch >> 9)] + (size_t)layer * NEXP_ * D_) + (size_t)(ch & 511) * 262144 + (size_t)(((F.wave >> 2) * 2048 + (F.wave & 3) * 512) * 4);
}
DEV void side_item(const Frame& F, int layer, int ch, SideSt& S) {
    S.isrc = side_src(F, layer, ch);
    S.idst = (GAS_ unsigned char*)(F.ws + ((ch >> 9) ? WS_V16 : WS_U16) + (size_t)layer * PEER_TBL + (size_t)(4 * (F.wave & 3)) * PEER_SLS + (size_t)(((ch & 511) * 32 + (F.wave >> 2)) * 128));
}
DEV void side_load(const Frame& F, SideSt& S, const GAS_ char* gb, int ln) {
    asm volatile("" : "+s"(gb));
    S.pa = *(const GAS_ f32x4*)(gb + (unsigned)ln * 32u); S.pb = *(const GAS_ f32x4*)(gb + ((unsigned)ln * 32u + 16u));
}
DEV void side_store(const Frame& F, const SideSt& S, int ln) {
    const f32x4 a = S.pa * S.g0, b = S.pb * S.g1;
    u32x2 o; o.x = pk4_fp8(a, 1.0f); o.y = pk4_fp8(b, 1.0f);
    GAS_ unsigned char* db = S.dcur; asm volatile("" : "+s"(db));
    *(GAS_ u32x2*)(db + ((unsigned)(ln >> 4) * (unsigned)PEER_SLS + 8u * (unsigned)(ln & 15))) = o;
}
DEV void side_step(const Frame& F, SideSt& S, int j) {
    int ln = F.lane; asm volatile("" : "+v"(ln));
    __builtin_amdgcn_sched_barrier(0);
    asm volatile("" : "+v"(S.pa), "+v"(S.pb));
    side_store(F, S, ln);
    side_load(F, S, S.isrc + (size_t)j * 16384, ln);
    S.dcur = S.idst + (size_t)j * 256;
    __builtin_amdgcn_sched_barrier(0);
}
#define SIDE_STEP(j) side_step(F, sst, (j))
#define HSYNC() do { asm volatile("s_waitcnt lgkmcnt(0)" ::: "memory"); __builtin_amdgcn_s_barrier(); asm volatile("" ::: "memory"); } while (0)
#define WSYNC() asm volatile("" ::: "memory")
DEV void phase_hyena(const Frame& F, int layer) {
    lcf dbuf = (lcf)F.lds + (F.tid >> 8) * FFT_BUF_ELEMS;
    lcf spec0 = (lcf)F.lds + 2 * FFT_BUF_ELEMS, spec1 = spec0 + FFT_BUF_ELEMS;
    LAS float* red = (LAS float*)(F.lds + 4 * FFT_BUF_ELEMS * 8);
    LAS bf16_t* stg = (LAS bf16_t*)spec0;
    const int fl = F.tid >> 8, r = F.tid & 255, w4 = (F.tid >> 6) & 3;
    const bf16_t* hyt = WSP(bf16_t, WS_HYT);
    const _Float16* filt = WSP(_Float16, WS_FILT) + (size_t)layer * 4096 * 2048;
    const float* cw = F.P->in[7] + (size_t)layer * 3 * 3072; const float* cb = F.P->in[8] + (size_t)layer * 3072; const float* fbias = F.P->in[15] + (size_t)layer * 2 * HW_;
    bf16_t* z2t = WSP(bf16_t, WS_Z2T);
    SideSt sst; side_item(F, layer, F.c, sst);
    { int ln = F.lane; asm volatile("" : "+v"(ln)); side_load(F, sst, sst.isrc, ln); sst.dcur = sst.idst; }
    const float* sgp = F.P->in[18] + (size_t)layer * D_ + (F.wave & 3) * 512 + 8 * F.lane;
    if ((F.c >> 9) == 0) { sst.g0 = *(const f32x4*)sgp * PEER_U_SCALE; sst.g1 = *(const f32x4*)(sgp + 4) * PEER_U_SCALE; } else { sst.g0 = PEER_V_SCALE; sst.g1 = PEER_V_SCALE; }
    for (int ch = F.c; ch < HW_; ch += F.G) {
        float hfraw[8], hbraw[8];
        { const int o = fl, rb = (256 - r) & 255;
          const _Float16* hfp = filt + (size_t)((0 * 2 + o) * HW_ + ch) * L_; const _Float16* hbp = filt + (size_t)((1 * 2 + o) * HW_ + ch) * L_;
#pragma unroll
          for (int a = 0; a < 8; ++a) { hfraw[a] = (float)hfp[256 * a + r]; hbraw[a] = (float)hbp[256 * a + rb]; } }
        float cwv[3][4];
#pragma unroll
        for (int s = 0; s < 3; ++s) { const int cc = s * HW_ + ch; cwv[s][0] = cw[cc]; cwv[s][1] = cw[3072 + cc]; cwv[s][2] = cw[2 * 3072 + cc]; cwv[s][3] = cb[cc]; }
        float fb0 = fbias[ch], fb1 = fbias[HW_ + ch];
        side_item(F, layer, ch, sst);
        f32x4 tg0, tg1; if ((ch >> 9) == 0) { tg0 = *(const f32x4*)sgp * PEER_U_SCALE; tg1 = *(const f32x4*)(sgp + 4) * PEER_U_SCALE; } else { tg0 = PEER_V_SCALE; tg1 = PEER_V_SCALE; }
#pragma unroll
        for (int i = 0; i < 6; ++i) { const int q = F.tid + i * NTHREADS, s = q >> 10, off = (q & 1023) * 8;
            const u32x4 v = *(const u32x4*)(hyt + (size_t)(s * HW_ + ch) * T_ + off);
            LAS unsigned* d = (LAS unsigned*)(stg + s * 8192 + off); d[0] = v.x; d[1] = v.y; d[2] = v.z; d[3] = v.w; }
#pragma unroll
        for (int a = 0; a < 8; ++a) { asm volatile("" : "+v"(hfraw[a])); asm volatile("" : "+v"(hbraw[a])); }
        asm volatile("" : "+v"(fb0)); asm volatile("" : "+v"(fb1));
        asm volatile("" : "+v"(tg0)); asm volatile("" : "+v"(tg1));
#pragma unroll
        for (int s = 0; s < 3; ++s) { asm volatile("" : "+v"(cwv[s][0])); asm volatile("" : "+v"(cwv[s][1])); asm volatile("" : "+v"(cwv[s][2])); asm volatile("" : "+v"(cwv[s][3])); }
        SIDE_STEP(0);
        sst.g0 = tg0; sst.g1 = tg1;
        HSYNC();
        float vv[2][8], x1v[2][8], x2v[2][8];
#pragma unroll
        for (int s = 0; s < 3; ++s) {
            const float w0 = cwv[s][0], w1 = cwv[s][1], w2 = cwv[s][2], bb = cwv[s][3];
#pragma unroll
            for (int b2 = 0; b2 < 2; ++b2) { const LAS bf16_t* row = stg + s * 8192 + (2 * fl + b2) * 2048;
#pragma unroll
                for (int a = 0; a < 8; ++a) { const int t = 256 * a + r;
                    const float um = (t > 0) ? bf1(row[t - 1]) : 0.f, u0 = bf1(row[t]), up = (t < L_ - 1) ? bf1(row[t + 1]) : 0.f;
                    const float val = w0 * um + w1 * u0 + w2 * up + bb;
                    if (s == 0) vv[b2][a] = val; else if (s == 1) x1v[b2][a] = val; else x2v[b2][a] = val; }
                __builtin_amdgcn_sched_barrier(0); }
            if (s >= 1) SIDE_STEP(s);
        }
        HSYNC();
        {
            const int o = fl, rb = (256 - r) & 255;
            const float delta = fabsf(-3.0701134573253945f + (float)ch * ((-15.350567286626973f + 3.0701134573253945f) / 1023.0f));
            float hfv[8], hbv[8], sf = 0.f, sb = 0.f;
#pragma unroll
            for (int a = 0; a < 8; ++a) { const int l1 = 256 * a + r, l2 = 256 * a + rb;
                hfv[a] = hfraw[a] * __expf(-delta * (float)l1 * (1.0f / 2047.0f)); hbv[a] = hbraw[a] * __expf(-delta * (float)l2 * (1.0f / 2047.0f));
                sf += fabsf(hfv[a]); sb += fabsf(hbv[a]); }
            sf = wave_sum(sf); sb = wave_sum(sb);
            if (F.lane == 0) { red[(fl * 2 + 0) * 4 + w4] = sf; red[(fl * 2 + 1) * 4 + w4] = sb; }
            HSYNC();
            const float nf = red[(fl * 2 + 0) * 4 + 0] + red[(fl * 2 + 0) * 4 + 1] + red[(fl * 2 + 0) * 4 + 2] + red[(fl * 2 + 0) * 4 + 3] + 1e-6f;
            const float nb = red[(fl * 2 + 1) * 4 + 0] + red[(fl * 2 + 1) * 4 + 1] + red[(fl * 2 + 1) * 4 + 2] + red[(fl * 2 + 1) * 4 + 3] + 1e-6f;
            const float kf = (1.0f / 4096.0f) / nf, kb = (1.0f / 4096.0f) / nb;
            cf x[16];
#pragma unroll
            for (int a = 0; a < 8; ++a) x[a] = CF(hfv[a] * kf, 0.f);
            if (r != 0) {
#pragma unroll
                for (int k = 0; k < 8; ++k) x[8 + k] = CF(hbv[7 - k] * kb, 0.f);
            } else {
                x[8] = CF(0.f, 0.f);
#pragma unroll
                for (int k = 1; k < 8; ++k) x[8 + k] = CF(hbv[8 - k] * kb, 0.f);
                x[0].x += hbv[0] * kb;
            }
            fft_s1f(x, dbuf, r);
            SIDE_STEP(3);
            HSYNC();
            fft_s2f(dbuf, r);
            SIDE_STEP(4);
            WSYNC();
            fft_s3f(x, dbuf, r);
            lcf sp = o ? spec1 : spec0; int ro = r; asm volatile("" : "+v"(ro)); const int b = ro >> 4, bp = ro & 15;
#pragma unroll
            for (int q = 0; q < 16; ++q) sp[272 * b + 17 * bp + q] = x[q];
            SIDE_STEP(5);
            HSYNC();
        }
#pragma unroll 1
        for (int o = 0; o < 2; ++o) {
            const float bias = o ? fb1 : fb0;
            cf x[16];
#pragma unroll
            for (int a = 0; a < 8; ++a) x[a] = CF(vv[0][a], vv[1][a]);
#pragma unroll
            for (int a = 8; a < 16; ++a) x[a] = CF(0.f, 0.f);
            fft_s1f(x, dbuf, r);
            SIDE_STEP(6 + 5 * o);
            HSYNC();
            fft_s2f(dbuf, r);
            SIDE_STEP(7 + 5 * o);
            WSYNC();
            fft_s3f(x, dbuf, r);
            { lcf sp = spec0 + o * FFT_BUF_ELEMS; int ro = r; asm volatile("" : "+v"(ro)); const int b = ro >> 4, bp = ro & 15;
#pragma unroll
              for (int q = 0; q < 16; ++q) x[q] = cmul(x[q], sp[272 * b + 17 * bp + q]); }
            fft_s3i(x, dbuf, r);
            SIDE_STEP(8 + 5 * o);
            WSYNC();
            fft_s2i(dbuf, r);
            SIDE_STEP(9 + 5 * o);
            HSYNC();
            fft_s1i(x, dbuf, r);
#pragma unroll
            for (int a = 0; a < 8; ++a) {
                vv[0][a] = (x[a].x + bias * vv[0][a]) * x1v[0][a]; vv[1][a] = (x[a].y + bias * vv[1][a]) * x1v[1][a];
                x1v[0][a] = x2v[0][a]; x1v[1][a] = x2v[1][a];
            }
            SIDE_STEP(10 + 5 * o);
        }
#pragma unroll
        for (int b2 = 0; b2 < 2; ++b2)
#pragma unroll
            for (int a = 0; a < 8; ++a) z2t[(size_t)ch * T_ + (2 * fl + b2) * L_ + 256 * a + r] = f2bf(vv[b2][a]);
        HSYNC();
    }
    { int ln = F.lane; asm volatile("" : "+v"(ln)); side_store(F, sst, ln); }
}

DEV unsigned ord_key(float f, int k) { unsigned u = __float_as_uint(f); u ^= (u >> 31) ? 0xFFFFFFFFu : 0x80000000u; return (u & ~127u) | (unsigned)(127 - k); }
DEV float key_val(unsigned key) { unsigned u = key & ~127u; u = (u & 0x80000000u) ? (u ^ 0x80000000u) : ~u; return __uint_as_float(u); }
#define INS_U32(L, x) do { _Pragma("unroll") for (int _i = 0; _i < 16; ++_i) { const unsigned _hi = max(L[_i], x); x = min(L[_i], x); L[_i] = _hi; } } while (0)
template <bool DESC> DEV void sort16(unsigned (&K)[16]) {
#define CE(a, b) do { const unsigned _lo = min(K[a], K[b]), _hi = max(K[a], K[b]); K[a] = DESC ? _hi : _lo; K[b] = DESC ? _lo : _hi; } while (0)
    CE(0, 13); CE(1, 12); CE(2, 15); CE(3, 14); CE(4, 8); CE(5, 6); CE(7, 11); CE(9, 10);
    CE(0, 5); CE(1, 7); CE(2, 9); CE(3, 4); CE(6, 13); CE(8, 14); CE(10, 15); CE(11, 12);
    CE(0, 1); CE(2, 3); CE(4, 5); CE(6, 8); CE(7, 9); CE(10, 11); CE(12, 13); CE(14, 15);
    CE(0, 2); CE(1, 3); CE(4, 10); CE(5, 11); CE(6, 7); CE(8, 9); CE(12, 14); CE(13, 15);
    CE(1, 2); CE(3, 12); CE(4, 6); CE(5, 7); CE(8, 10); CE(9, 11); CE(13, 14);
    CE(1, 4); CE(2, 6); CE(5, 8); CE(7, 10); CE(9, 13); CE(11, 14);
    CE(2, 4); CE(3, 6); CE(9, 12); CE(11, 13);
    CE(3, 5); CE(6, 8); CE(7, 9); CE(10, 12);
    CE(3, 4); CE(5, 6); CE(7, 8); CE(9, 10); CE(11, 12);
    CE(6, 7); CE(8, 9);
#undef CE
}
DEV void merge_top16(unsigned (&L)[16], const unsigned (&K)[16]) {
#pragma unroll
    for (int i = 0; i < 16; ++i) L[i] = max(L[i], K[i]);
#pragma unroll
    for (int s = 8; s >= 1; s >>= 1)
#pragma unroll
        for (int i = 0; i < 16; ++i)
            if ((i & s) == 0) { const unsigned lo = min(L[i], L[i + s]), hi = max(L[i], L[i + s]); L[i] = hi; L[i + s] = lo; }
}
DEV unsigned cand_key(float f, int c) { unsigned u = __float_as_uint(f); u ^= (u >> 31) ? 0xFFFFFFFFu : 0x80000000u; return (u & ~255u) | (unsigned)(255 - c); }
DEV float cand_val(unsigned key) { unsigned u = key & ~255u; u = (u & 0x80000000u) ? (u ^ 0x80000000u) : ~u; return __uint_as_float(u); }
DEV void phase_topk(const Frame& F) {
    int* idx = WSP(int, WS_IDX); float* gate = WSP(float, WS_GATE);
    const int lane = F.lane, w4 = F.wave & 3, half = F.wave >> 2;
    LAS unsigned char* kown = F.lds + (half * 128) * (SC_LD * 2) + w4 * 128;
    LAS unsigned char* kpart = F.lds + 128 * (SC_LD * 2) + w4 * 128;
#define KEYAT(base, i, l) (*(LAS unsigned*)((base) + (2 * (i) + ((l) >> 5)) * (SC_LD * 2) + ((l) & 31) * 4))
    __syncthreads();
    {
        const int h = F.c >> 5, t = (F.c & 31) * 256 + w4 * 64 + lane;
        unsigned L1[16];
        {
            const LAS _Float16* sp = (const LAS _Float16*)F.lds + (half * 128) * SC_LD + w4 * 64 + lane;
            float cur[16], nxt[16];
#pragma unroll
            for (int i = 0; i < 16; ++i) cur[i] = (float)sp[i * SC_LD];
#pragma unroll
            for (int blk = 0; blk < 8; ++blk) {
                if (blk < 7) {
#pragma unroll
                    for (int i = 0; i < 16; ++i) nxt[i] = (float)sp[(16 * (blk + 1) + i) * SC_LD];
                }
                unsigned K[16];
#pragma unroll
                for (int i = 0; i < 16; ++i) K[i] = ord_key(cur[i], 16 * blk + i);
                if (blk == 0) {
                    sort16<true>(K);
#pragma unroll
                    for (int i = 0; i < 16; ++i) L1[i] = K[i];
                } else { sort16<false>(K); merge_top16(L1, K); }
#pragma unroll
                for (int i = 0; i < 16; ++i) cur[i] = nxt[i];
                __builtin_amdgcn_sched_barrier(0);
            }
#pragma unroll
            for (int i = 0; i < 16; ++i) KEYAT(kown, i, lane) = L1[i];
        }
        __syncthreads();
        if (half == 0) {
            float v1[16], v2[16];
#pragma unroll
            for (int i = 0; i < 16; ++i) { v1[i] = key_val(L1[i]); v2[i] = key_val(KEYAT(kpart, i, lane)); }
#define CK(I, J) cand_key(v1[I] + v2[J], 16 * (I) + (J))
            unsigned C[16];
#pragma unroll
            for (int j = 0; j < 16; ++j) C[j] = cand_key(v1[0] + v2[j], j);
            { unsigned K[16] = {CK(1, 0), CK(1, 1), CK(1, 2), CK(1, 3), CK(1, 4), CK(1, 5), CK(1, 6), CK(1, 7), CK(2, 0), CK(2, 1), CK(2, 2), CK(2, 3), CK(2, 4), CK(3, 0), CK(3, 1), CK(3, 2)};
              sort16<false>(K); merge_top16(C, K); }
            { unsigned K[16] = {CK(3, 3), CK(4, 0), CK(4, 1), CK(4, 2), CK(5, 0), CK(5, 1), CK(6, 0), CK(6, 1), CK(7, 0), CK(7, 1), CK(8, 0), CK(9, 0), CK(10, 0), CK(11, 0), CK(12, 0), CK(13, 0)};
              sort16<false>(K); merge_top16(C, K); }
            { unsigned x = CK(14, 0); INS_U32(C, x); unsigned y = CK(15, 0); INS_U32(C, y); }
#undef CK
            float e[16], ssum = 0.f; int cp[16];
            const float c0 = cand_val(C[0]);
#pragma unroll
            for (int i = 0; i < 16; ++i) {
                e[i] = __expf(cand_val(C[i]) - c0); ssum += e[i];
                const unsigned c = 255u - (C[i] & 255u);
                const unsigned k1 = KEYAT(kown, c >> 4, lane), k2 = KEYAT(kpart, c & 15u, lane);
                cp[i] = (127 - (int)(k1 & 127u)) * 128 + (127 - (int)(k2 & 127u));
            }
            const float inv = 1.0f / ssum;
            int* ip = idx + (size_t)t * 128 + h * 16; float* gp = gate + (size_t)t * 128 + h * 16;
#pragma unroll
            for (int q = 0; q < 4; ++q) {
                *(int4*)(ip + 4 * q) = make_int4(cp[4 * q], cp[4 * q + 1], cp[4 * q + 2], cp[4 * q + 3]);
                *(f32x4*)(gp + 4 * q) = (f32x4){e[4 * q] * inv, e[4 * q + 1] * inv, e[4 * q + 2] * inv, e[4 * q + 3] * inv};
            }
        }
        __syncthreads();
    }
#undef KEYAT
}

#define GAS __attribute__((address_space(1)))
template <class T> DEV GAS T* sptr(T* p) { GAS T* q = (GAS T*)p; asm volatile("" : "+s"(q)); return q; }
template <class T> DEV T gld(const GAS void* base, unsigned byteoff) { asm volatile("" : "+v"(byteoff)); return *(const GAS T*)((const GAS char*)base + byteoff); }
template <class T> DEV void gst(GAS void* base, unsigned byteoff, T v) { asm volatile("" : "+v"(byteoff)); *(GAS T*)((GAS char*)base + byteoff) = v; }
template <int CTRL> DEV float dppf(float x) { return __builtin_bit_cast(float, __builtin_amdgcn_mov_dpp(__builtin_bit_cast(int, x), CTRL, 0xf, 0xf, true)); }
constexpr int DPP_XOR1 = 0xB1, DPP_XOR2 = 0x4E, DPP_HMIR = 0x141, DPP_ROR8 = 0x128;
constexpr int PEER_NSL = 16, PEER_SLD = 128;
constexpr int PEER_TPW = T_ / (32 * NWAVES);
static_assert(NWAVES * PEER_TPW * 128 * 4 <= LDS_BYTES - 16, "U pass: first-slice partial sums in LDS");
constexpr size_t WS_PART = WS_PD;
static_assert(WS_AG - WS_PD == 64 * MiB, "partial-sum region");
typedef __bf16 bf16x2_t __attribute__((ext_vector_type(2)));
DEV float dot4_fp8_bf16(unsigned w, unsigned h01, unsigned h23, float acc) {
    acc = __builtin_amdgcn_fdot2_f32_bf16(__builtin_amdgcn_cvt_scalef32_pk_bf16_fp8(w, 1.0f, false), __builtin_bit_cast(bf16x2_t, h01), acc, false);
    return __builtin_amdgcn_fdot2_f32_bf16(__builtin_amdgcn_cvt_scalef32_pk_bf16_fp8(w, 1.0f, true), __builtin_bit_cast(bf16x2_t, h23), acc, false);
}
DEV float dot4_fp8(unsigned w, float h0, float h1, float h2, float h3, float acc) {
    const f32x2 lo = __builtin_amdgcn_cvt_pk_f32_fp8((int)w, false), hi = __builtin_amdgcn_cvt_pk_f32_fp8((int)w, true);
    return acc + lo.x * h0 + lo.y * h1 + hi.x * h2 + hi.y * h3;
}
#define UNPACK_HF(HF, H0, H1) do { HF[0] = bf_lo(H0.x); HF[1] = bf_hi(H0.x); HF[2] = bf_lo(H0.y); HF[3] = bf_hi(H0.y); HF[4] = bf_lo(H0.z); HF[5] = bf_hi(H0.z); HF[6] = bf_lo(H0.w); HF[7] = bf_hi(H0.w); \
        HF[8] = bf_lo(H1.x); HF[9] = bf_hi(H1.x); HF[10] = bf_lo(H1.y); HF[11] = bf_hi(H1.y); HF[12] = bf_lo(H1.z); HF[13] = bf_hi(H1.z); HF[14] = bf_lo(H1.w); HF[15] = bf_hi(H1.w); } while (0)
struct PeerRowU { u32x4 h0, h1; int i0, i1; };
#define PEER_SU(R, TT) do { const int _t = t0 + min((TT), tpw - 1); const GAS bf16_t* _xr = sptr(xn + (size_t)_t * D_ + sl * PEER_SLD); R.h0 = gld<u32x4>(_xr, uj16 * 2u); R.h1 = gld<u32x4>(_xr, uj16 * 2u + 16u); \
        const GAS int* _ir = sptr(idx + (size_t)_t * 128); R.i0 = gld<int>(_ir, ulane * 4u); R.i1 = gld<int>(_ir, ulane * 4u + 256u); } while (0)
#define PEER_GU(UQ, R) do { _Pragma("unroll") for (int i = 0; i < 16; ++i) { const int e = __builtin_amdgcn_ds_bpermute(((i & 7) * 8 + g) << 2, (i < 8) ? R.i0 : R.i1); UQ[i] = *(const GAS u32x4*)(Ug + (sbase + ((unsigned)e << 7))); } } while (0)
#define PEER_CU(UQ, R, TT) do { float p[16]; \
        _Pragma("unroll") for (int i = 0; i < 16; ++i) { float d = dot4_fp8_bf16(UQ[i].x, R.h0.x, R.h0.y, 0.f); d = dot4_fp8_bf16(UQ[i].y, R.h0.z, R.h0.w, d); \
            d = dot4_fp8_bf16(UQ[i].z, R.h1.x, R.h1.y, d); d = dot4_fp8_bf16(UQ[i].w, R.h1.z, R.h1.w, d); \
            d += dppf<DPP_XOR1>(d); d += dppf<DPP_XOR2>(d); d += dppf<DPP_HMIR>(d); p[i] = d; } \
        float v0 = p[0], v1 = p[8]; \
        _Pragma("unroll") for (int i = 1; i < 8; ++i) { v0 = (j8 == i) ? p[i] : v0; v1 = (j8 == i) ? p[8 + i] : v1; } \
        if (COMMIT) { LAS float* lp = (LAS float*)F.lds + ((F.wave * PEER_TPW + (TT)) * 128 + (int)uslot);     \
            if (j == 0) { lp[0] = v0; lp[64] = v1; } \
            else { v0 += lp[0]; v1 += lp[64]; GAS bf16_t* po = sptr(part + ((size_t)xl * T_ + t0 + (TT)) * 128); gst<unsigned>(po, uslot * 4u, cvt_pk_bf16(v0, v1));     } \
        } else { asm volatile("" :: "v"(v0), "v"(v1)); } } while (0)
#define SB() __builtin_amdgcn_sched_barrier(0)
template <bool COMMIT, bool SIDE> DEV void phase_peer_u(const Frame& F, int layer) {
    const bf16_t* xn = WSP(bf16_t, WS_XN); const int* idx = WSP(int, WS_IDX);
    const GAS unsigned char* Ug = (const GAS unsigned char*)(WSP(unsigned char, WS_U16) + (size_t)layer * PEER_TBL);
    bf16_t* part = WSP(bf16_t, WS_PART);
    const int lane0 = F.lane, xl = F.c & 7, rk = F.c >> 3, nrk = F.G >> 3, tpw = T_ / (nrk * NWAVES);
    const int t0 = (rk * NWAVES + F.wave) * tpw;
#pragma unroll 1
    for (int j = 0; j < PEER_NSL / 8; ++j) {
        const int sl = xl + 8 * j;
        const unsigned sbase0 = (unsigned)sl * (unsigned)PEER_SLS;
        PeerRowU ra, rb, na, nb;
        u32x4 uqA[16], uqB[16];
        { int lane_o = lane0; asm volatile("" : "+v"(lane_o));
          const int lane = lane_o, g = lane >> 3, j8 = lane & 7; const unsigned ulane = (unsigned)lane, uj16 = (unsigned)j8 * 16u;
          const unsigned sbase = sbase0 + (unsigned)j8 * 16u;
          PEER_SU(ra, 0); PEER_SU(rb, 1); SB(); PEER_GU(uqA, ra); SB(); PEER_SU(na, 2); SB(); PEER_GU(uqB, rb); SB(); PEER_SU(nb, 3); SB(); }
#pragma unroll 1
        for (int tt = 0; tt < tpw; tt += 2) {
            int lane_o = lane0; asm volatile("" : "+v"(lane_o));
            const int lane = lane_o, g = lane >> 3, j8 = lane & 7; const unsigned ulane = (unsigned)lane, uj16 = (unsigned)j8 * 16u, uslot = (unsigned)(j8 * 8 + g);
            const unsigned sbase = sbase0 + (unsigned)j8 * 16u;
            const bool more = tt + 2 < tpw;
            PEER_CU(uqA, ra, tt); SB();
            ra = na;
            if (more) { PEER_GU(uqA, ra); }
            SB();
            PEER_SU(na, tt + 4); SB();
            PEER_CU(uqB, rb, tt + 1); SB();
            rb = nb;
            if (more) { PEER_GU(uqB, rb); }
            SB();
            PEER_SU(nb, tt + 5); SB();
        }
    }
}
DEV void phase_peer_act(const Frame& F, int layer) {
    const bf16_t* part = WSP(bf16_t, WS_PART); float* gate = WSP(float, WS_GATE); const ss_t* ssf = WSP(ss_t, WS_SS) + (size_t)(3 * layer + 1) * T_;
    const int tstep = F.G * NWAVES;
    for (int t = F.c * NWAVES + F.wave; t < T_; t += 2 * tstep) {
        unsigned w[2][PEER_NSL / 2]; float gv[2][2]; int iv[2][2]; float rs[2];
#pragma unroll
        for (int k = 0; k < 2; ++k) { const int tk = t + k * tstep;
#pragma unroll
            for (int sl = 0; sl < PEER_NSL / 2; ++sl) w[k][sl] = ((const unsigned*)(part + ((size_t)sl * T_ + tk) * 128))[F.lane];
            const float* gp = gate + (size_t)tk * 128; const int* ip = WSP(int, WS_IDX) + (size_t)tk * 128;
            gv[k][0] = gp[F.lane]; gv[k][1] = gp[64 + F.lane]; iv[k][0] = ip[F.lane]; iv[k][1] = ip[64 + F.lane];
            rs[k] = rstd_of(ssf[tk]) * (1.0f / PEER_U_SCALE); }
#pragma unroll
        for (int k = 0; k < 2; ++k) { const int tk = t + k * tstep; float h0 = 0.f, h1 = 0.f;
#pragma unroll
            for (int sl = 0; sl < PEER_NSL / 2; ++sl) { h0 += bf_lo(w[k][sl]); h1 += bf_hi(w[k][sl]); }
            unsigned* pk = (unsigned*)(gate + (size_t)tk * 128);
            const float a0 = gv[k][0] * gelu_erf(h0 * rs[k]) * (1.0f / PEER_V_SCALE), a1 = gv[k][1] * gelu_erf(h1 * rs[k]) * (1.0f / PEER_V_SCALE);
            pk[F.lane] = (cvt_pk_bf16(0.f, a0) & 0xffff0000u) | (unsigned)iv[k][0]; pk[64 + F.lane] = (cvt_pk_bf16(0.f, a1) & 0xffff0000u) | (unsigned)iv[k][1]; }
    }
}
#define PEER_ACC4(W, K) do { const f32x2 _lo = __builtin_amdgcn_cvt_pk_f32_fp8((int)(W), false), _hi = __builtin_amdgcn_cvt_pk_f32_fp8((int)(W), true); \
        acc2[(K) / 2] = a2 * _lo + acc2[(K) / 2]; acc2[(K) / 2 + 1] = a2 * _hi + acc2[(K) / 2 + 1]; } while (0)
struct PeerRowV { unsigned p0, p1; };
#define PEER_SV(R, TT) do { const int _t = t0 + min((TT), tpw - 1); const GAS unsigned* _pr = sptr(pkw + (size_t)_t * 128); \
        R.p0 = gld<unsigned>(_pr, ulane * 4u); R.p1 = gld<unsigned>(_pr, ulane * 4u + 256u); } while (0)
#define PEER_GV(VQ, AW, R) do { _Pragma("unroll") for (int i = 0; i < 16; ++i) { AW[i] = (unsigned)__builtin_amdgcn_ds_bpermute(((i & 7) * 8 + g) << 2, (int)((i < 8) ? R.p0 : R.p1)); \
        unsigned _off; asm("v_mad_u32_u16 %0, %1, %2, %3" : "=v"(_off) : "v"(AW[i]), "s"(128u), "v"(sbase));     \
        VQ[i] = *(const GAS u32x4*)(Vg + _off); } } while (0)
DEV float half_sum16(float a, float b) { const u32x2 r = __builtin_amdgcn_permlane16_swap(__float_as_uint(a), __float_as_uint(b), false, false); return __uint_as_float(r.x) + __uint_as_float(r.y); }
DEV float half_sum32(float a, float b) { const u32x2 r = __builtin_amdgcn_permlane32_swap(__float_as_uint(a), __float_as_uint(b), false, false); return __uint_as_float(r.x) + __uint_as_float(r.y); }
template <bool COMMIT> DEV void peer_cv(const u32x4 (&vq)[16], const unsigned (&aw)[16], unsigned hw, int t, int tl, float& ssacc, int sl, int lane, int g, int j8, bf16_t* hb) {
    f32x2 acc2[8];
#pragma unroll
    for (int k = 0; k < 8; ++k) acc2[k] = (f32x2){0.f, 0.f};
#pragma unroll
    for (int i = 0; i < 16; ++i) { const float a = __uint_as_float(aw[i] & 0xffff0000u); const f32x2 a2 = (f32x2){a, a};
        PEER_ACC4(vq[i].x, 0); PEER_ACC4(vq[i].y, 4); PEER_ACC4(vq[i].z, 8); PEER_ACC4(vq[i].w, 12); }
    float acc[16];
#pragma unroll
    for (int k = 0; k < 8; ++k) { acc[2 * k] = acc2[k].x; acc[2 * k + 1] = acc2[k].y; }
    float c8[8], c4[4], f0, f1;
#pragma unroll
    for (int k = 0; k < 8; ++k) c8[k] = half_sum32(acc[k], acc[8 + k]);
#pragma unroll
    for (int k = 0; k < 4; ++k) c4[k] = half_sum16(c8[k], c8[4 + k]);
    { const bool b3 = (lane & 8) != 0;
      const float k0 = b3 ? c4[2] : c4[0], k1 = b3 ? c4[3] : c4[1], s0 = b3 ? c4[0] : c4[2], s1 = b3 ? c4[1] : c4[3];
      f0 = k0 + dppf<DPP_ROR8>(s0); f1 = k1 + dppf<DPP_ROR8>(s1); }
    if (!COMMIT) { asm volatile("" :: "v"(f0), "v"(f1)); }
    else { GAS bf16_t* hbrow = sptr(hb + (size_t)t * D_ + sl * PEER_SLD);
        const float x0 = bf_lo(hw) + f0, x1 = bf_hi(hw) + f1;
        gst<unsigned>(hbrow, (unsigned)j8 * 32u + (unsigned)g * 4u, cvt_pk_bf16(x0, x1));
        float s2 = x0 * x0 + x1 * x1;
        s2 += dppf<DPP_XOR1>(s2); s2 += dppf<DPP_XOR2>(s2); s2 += dppf<DPP_HMIR>(s2); s2 += dppf<DPP_ROR8>(s2); s2 = sum_xor16(s2); s2 = sum_xor32(s2);
        ssacc = (lane == tl) ? s2 : ssacc; }
}
template <bool COMMIT> DEV void phase_peer_v(const Frame& F, int layer) {
    const unsigned* pkw = WSP(unsigned, WS_GATE);
    const GAS unsigned char* Vg = (const GAS unsigned char*)(WSP(unsigned char, WS_V16) + (size_t)layer * PEER_TBL);
    bf16_t* hb = WSP(bf16_t, WS_XN); ss_t* ssp = WSP(ss_t, WS_SS) + (size_t)(3 * layer + 2) * T_;
    const int lane0 = F.lane, xl = F.c & 7, rk = F.c >> 3, nrk = F.G >> 3, tpw = T_ / (nrk * NWAVES);
    const int t0 = (rk * NWAVES + F.wave) * tpw;
#pragma unroll 1
    for (int j = 0; j < PEER_NSL / 8; ++j) {
        const int sl = xl + 8 * j;
        const unsigned sbase0 = (unsigned)sl * (unsigned)PEER_SLS;
        PeerRowV ra, rb, na, nb; float ssacc = 0.f;
        { const unsigned ulane = (unsigned)lane0; PEER_SV(ra, 0); PEER_SV(rb, 1); }
#pragma unroll 1
        for (int tt = 0; tt < tpw; tt += 2) {
            int lane_o = lane0; asm volatile("" : "+v"(lane_o));
            const int lane = lane_o, g = lane >> 3, j8 = lane & 7, x32addr = (lane ^ 32) << 2; const unsigned ulane = (unsigned)lane;
            const unsigned sbase = sbase0 + (unsigned)j8 * 16u;
            unsigned hA, hB;
            { const GAS bf16_t* ha = sptr(hb + (size_t)(t0 + tt) * D_ + sl * PEER_SLD); const GAS bf16_t* hbp = sptr(hb + (size_t)(t0 + tt + 1) * D_ + sl * PEER_SLD);
              hA = gld<unsigned>(ha, (unsigned)j8 * 32u + (unsigned)g * 4u); hB = gld<unsigned>(hbp, (unsigned)j8 * 32u + (unsigned)g * 4u); }
            SB();
            u32x4 vqA[16], vqB[16]; unsigned awA[16], awB[16];
            PEER_GV(vqA, awA, ra); PEER_GV(vqB, awB, rb); SB();
            PEER_SV(na, tt + 2); PEER_SV(nb, tt + 3); SB();
            peer_cv<COMMIT>(vqA, awA, hA, t0 + tt, tt, ssacc, sl, lane, g, j8, hb); SB();
            peer_cv<COMMIT>(vqB, awB, hB, t0 + tt + 1, tt + 1, ssacc, sl, lane, g, j8, hb); SB();
            ra = na; rb = nb;
        }
        if (COMMIT && lane0 < tpw) { GAS ss_t* sp = sptr(ssp + t0); const ss_t sv = ss_fix(ssacc); const unsigned zoff = (unsigned)lane0 * 8u; asm volatile("global_atomic_add_x2 %0, %1, %2" :: "v"(zoff), "v"(sv), "s"(sp)); }
    }
}

enum { K_FILT = 0, K_PPROJ, K_POOLIN, K_GATES, K_HYT, K_WCOMB, K_AG, K_MIX, K_RES, K_WQK, K_SCORES, K_PLE };

#define KM(k) (1u << (k))
DEV unsigned gate_pk4(f32x4 g) { return (unsigned)(g[0] * 255.0f + 0.5f) | ((unsigned)(g[1] * 255.0f + 0.5f) << 8) | ((unsigned)(g[2] * 255.0f + 0.5f) << 16) | ((unsigned)(g[3] * 255.0f + 0.5f) << 24); }
DEV f32x4 gate_un4(unsigned q) { return (f32x4){(float)(q & 255u), (float)((q >> 8) & 255u), (float)((q >> 16) & 255u), (float)(q >> 24)} * (1.0f / 255.0f); }
template <unsigned KINDS> struct EpiAll {
    unsigned char* ws; const float* x_in; const float* pool_scale; int layer;
    const ss_t* ss_in;
    ss_t* ss_out;
    LAS unsigned char* lds = nullptr;
    template <unsigned K> static constexpr bool has() { return (KINDS & KM(K)) != 0u; }
    static constexpr int GROUP_ROWS = 4;
    __device__ __forceinline__ void unit_begin(const Unit& u, int wr, int wc, int fr, int fq, pg8::EpiCtx& c) const {
        if constexpr (has<K_POOLIN>() || has<K_GATES>() || has<K_PLE>()) if (u.kind == K_POOLIN || u.kind == K_GATES || u.kind == K_PLE) {
#pragma unroll
            for (int r8 = 0; r8 < 8; ++r8) c.rs[r8] = rstd_of(ss_in[u.i0 + (r8 >> 2) * 128 + wr * 64 + (r8 & 3) * 16 + fr]);
        }
        if constexpr (has<K_HYT>() || has<K_SCORES>()) if (u.kind == K_HYT || u.kind == K_SCORES) {
#pragma unroll
            for (int bj = 0; bj < 2; ++bj) { const ss_t* sp = ss_in + u.i1 + bj * 128 + wc * 32 + 8 * fq;
#pragma unroll
                for (int k = 0; k < 8; ++k) c.cs[bj * 8 + k] = rstd_of(sp[k]); }
        }
        if constexpr (has<K_SCORES>()) if (u.kind == K_SCORES) { asm volatile("s_waitcnt vmcnt(0)" ::: "memory"); __syncthreads(); }
    }
    __device__ __forceinline__ void pre(const Unit& u, int row, int col, pg8::EpiPre& p) const {
        const int R = u.i0 + row, C = u.i1 + col;
        if constexpr (has<K_AG>()) if (u.kind == K_AG) { const u32x2 q = *(const u32x2*)((const unsigned char*)(ws + WS_GATES) + (size_t)R * 4096 + C); p.a.x = q.x; p.a.y = q.y; }
        if constexpr (has<K_MIX>()) if (u.kind == K_MIX) { const u32x2 q = *(const u32x2*)((const unsigned char*)(ws + WS_GATES) + (size_t)R * 4096 + 2048 + C); p.a.x = q.x; p.a.y = q.y; p.b = *(const u32x4*)((const bf16_t*)(ws + WS_AG) + (size_t)R * D_ + C); }
        if constexpr (has<K_RES>()) if (u.kind == K_RES) { if (layer == 0) { const u32x4* hi = (const u32x4*)(x_in + (size_t)R * D_ + C); p.a = hi[0]; p.b = hi[1]; }
            else p.a = *(const u32x4*)((const bf16_t*)(ws + WS_HB1) + (size_t)R * D_ + C); }
        if constexpr (has<K_PLE>()) if (u.kind == K_PLE) { p.a = *(const u32x4*)((const bf16_t*)(ws + WS_XN) + (size_t)R * D_ + C);
            p.c = *(const u32x4*)((const bf16_t*)(ws + WS_PPROJ) + ((size_t)layer * T_ + R) * D_ + C); }
    }
    __device__ __forceinline__ float store(const Unit& u, int row, int col, f32x4 v0, f32x4 v1, const pg8::EpiPre& p, const pg8::EpiCtx& c, int r8, int bj) const {
        const int R = u.i0 + row, C = u.i1 + col;
        switch (u.kind) {
        case K_FILT: if constexpr (has<K_FILT>()) { _Float16* o = (_Float16*)(ws + WS_FILT) + ((size_t)u.i2 * 4096 + R) * 2048 + C;
                      typedef _Float16 f16x8_t __attribute__((ext_vector_type(8)));
                      const f16x8_t hv = {(_Float16)v0[0], (_Float16)v0[1], (_Float16)v0[2], (_Float16)v0[3], (_Float16)v1[0], (_Float16)v1[1], (_Float16)v1[2], (_Float16)v1[3]};
                      *(f16x8_t*)o = hv; } break;
        case K_PPROJ: if constexpr (has<K_PPROJ>()) st_bf16x8((bf16_t*)(ws + WS_PPROJ) + ((size_t)u.i2 * T_ + R) * D_ + C, v0, v1); break;
        case K_POOLIN: if constexpr (has<K_POOLIN>()) { const float r = c.rs[r8]; st_bf16x8((bf16_t*)(ws + WS_POOLIN) + (size_t)R * PW_ + C, v0 * r, v1 * r); } break;
        case K_GATES: if constexpr (has<K_GATES>()) { const float r = c.rs[r8]; u32x2 q; q.x = gate_pk4(sig4(v0 * r)); q.y = gate_pk4(sig4(v1 * r)); *(u32x2*)((unsigned char*)(ws + WS_GATES) + (size_t)R * 4096 + C) = q; } break;
        case K_HYT: if constexpr (has<K_HYT>()) { const f32x4 r0 = (f32x4){c.cs[bj * 8 + 0], c.cs[bj * 8 + 1], c.cs[bj * 8 + 2], c.cs[bj * 8 + 3]}, r1 = (f32x4){c.cs[bj * 8 + 4], c.cs[bj * 8 + 5], c.cs[bj * 8 + 6], c.cs[bj * 8 + 7]};
                      st_bf16x8((bf16_t*)(ws + WS_HYT) + (size_t)R * T_ + C, v0 * r0, v1 * r1); } break;
        case K_WCOMB: if constexpr (has<K_WCOMB>()) st_bf16x8((bf16_t*)(ws + WS_WCOMB) + ((size_t)u.i2 * D_ + R) * PW_ + C, v0, v1); break;
        case K_AG: if constexpr (has<K_AG>()) { const f32x4 g0 = gate_un4(p.a.x), g1 = gate_un4(p.a.y); st_bf16x8((bf16_t*)(ws + WS_AG) + (size_t)R * D_ + C, v0 * g0, v1 * g1); } break;
        case K_MIX: if constexpr (has<K_MIX>()) { f32x4 a0, a1; const f32x4 g0 = gate_un4(p.a.x), g1 = gate_un4(p.a.y); unpk8(p.b, a0, a1); st_bf16x8((bf16_t*)(ws + WS_MIX) + (size_t)R * D_ + C, a0 + v0 * g0, a1 + v1 * g1); } break;
        case K_RES: if constexpr (has<K_RES>()) { f32x4 x0, x1; if (layer == 0) { x0 = __builtin_bit_cast(f32x4, p.a); x1 = __builtin_bit_cast(f32x4, p.b); } else unpk8(p.a, x0, x1);
                      const f32x4 h0 = x0 + v0, h1 = x1 + v1;
                      st_bf16x8((bf16_t*)(ws + WS_XN) + (size_t)R * D_ + C, h0, h1); return ssq8(h0, h1); } break;
        case K_WQK: if constexpr (has<K_WQK>()) st_bf16x8((bf16_t*)(ws + WS_WQK) + ((size_t)u.i2 + R) * D_ + C, v0, v1); break;
        case K_SCORES: if constexpr (has<K_SCORES>()) { LAS _Float16* o = (LAS _Float16*)lds + row * SC_LD + col;
                      const f32x4 s0 = v0 * (f32x4){c.cs[bj * 8 + 0], c.cs[bj * 8 + 1], c.cs[bj * 8 + 2], c.cs[bj * 8 + 3]}, s1 = v1 * (f32x4){c.cs[bj * 8 + 4], c.cs[bj * 8 + 5], c.cs[bj * 8 + 6], c.cs[bj * 8 + 7]};
                      typedef _Float16 f16x8_t __attribute__((ext_vector_type(8)));
                      const f16x8_t hv = {(_Float16)s0[0], (_Float16)s0[1], (_Float16)s0[2], (_Float16)s0[3], (_Float16)s1[0], (_Float16)s1[1], (_Float16)s1[2], (_Float16)s1[3]};
                      *(LAS f16x8_t*)o = hv; } break;
        case K_PLE: if constexpr (has<K_PLE>()) { f32x4 p0, p1, x0, x1; unpk8(p.c, p0, p1); unpk8(p.a, x0, x1); const float r = c.rs[r8];
                      const f32x4 h0 = x0 + sig4(v0 * r) * p0, h1 = x1 + sig4(v1 * r) * p1;
                      st_bf16x8((bf16_t*)(ws + WS_HB1) + (size_t)R * D_ + C, h0, h1); return ssq8(h0, h1); } break;
        }
        return 0.f;
    }
    __device__ __forceinline__ void row_done(const Unit& u, int row, float ssq, int lane) const {
        if constexpr ((KINDS & (KM(K_RES) | KM(K_PLE))) != 0u) if (u.kind == K_RES || u.kind == K_PLE) {
            ssq += swz_xor16(ssq);
            ssq += __builtin_bit_cast(float, __builtin_amdgcn_ds_bpermute((lane ^ 32) << 2, __builtin_bit_cast(int, ssq)));
            if (lane < 16) atomicAdd(ss_out + u.i0 + row, ss_fix(ssq));
        }
    }
};

#define TILE_BYTES(ld) ((size_t)256 * (ld) * 2)
struct DecP0b {
    unsigned char* ws;
    __device__ __forceinline__ void decode(int idx, Unit& u) const {
        if (idx < 256) { const int l = idx >> 7, r = idx & 127, pm = r >> 3, pn = r & 7;
            u.a = (const char*)(ws + WS_W3A) + (size_t)l * 4096 * 512 + (size_t)pm * TILE_BYTES(256); u.b = (const char*)(ws + WS_HB) + (size_t)l * 2048 * 512 + (size_t)pn * TILE_BYTES(256);
            u.kind = K_FILT; u.i0 = pm * 256; u.i1 = pn * 256; u.i2 = l; }
        else { const int v = idx - 256, l = v >> 8, r = v & 255, pm = r & 31, pn = r >> 5;
            u.a = (const char*)(ws + WS_P16) + (size_t)l * T_ * 512 + (size_t)pm * TILE_BYTES(256); u.b = (const char*)(ws + WS_WP_T) + (size_t)l * D_ * 512 + (size_t)pn * TILE_BYTES(256);
            u.kind = K_PPROJ; u.i0 = pm * 256; u.i1 = pn * 256; u.i2 = l; }
    }
};
struct DecG1 {
    unsigned char* ws; int layer;
    __device__ __forceinline__ void decode(int idx, Unit& u) const {
        const char* xn = (const char*)(ws + (layer == 0 ? WS_XN : WS_HB1)); const char* w = (const char*)(ws + WS_WIN_T) + (size_t)layer * INC_ * D_ * 2;
        if (idx < 640) { const int pm = idx & 31, j = idx >> 5, pnw = (j < 4) ? j : j + 12;
            u.a = xn + (size_t)pm * TILE_BYTES(D_); u.b = w + (size_t)pnw * TILE_BYTES(D_);
            if (j < 4) { u.kind = K_POOLIN; u.i0 = pm * 256; u.i1 = pnw * 256; } else { u.kind = K_GATES; u.i0 = pm * 256; u.i1 = (pnw - 16) * 256; }
            u.i2 = 0; }
        else { const int v = idx - 640, pn = v & 31, pmw = 4 + (v >> 5);
            u.a = w + (size_t)pmw * TILE_BYTES(D_); u.b = xn + (size_t)pn * TILE_BYTES(D_);
            u.kind = K_HYT; u.i0 = (pmw - 4) * 256; u.i1 = pn * 256; u.i2 = 0; }
    }
};
struct DecSimple {
    const char* A; const char* B; int lda, ldb, nM, kind, a_col_step  , b_tile_rows  ;
    __device__ __forceinline__ void decode(int idx, Unit& u) const {
        const int pm = idx % nM, pn = idx / nM;
        u.a = A + (size_t)pm * TILE_BYTES(lda) + (size_t)pn * a_col_step; u.b = B + (size_t)pn * b_tile_rows * ldb * 2;
        u.kind = kind; u.i0 = pm * 256; u.i1 = pn * 256; u.i2 = 0;
    }
};

struct DecScores {
    unsigned char* ws; int layer;
    __device__ __forceinline__ void decode(int idx, Unit& u) const {
        const int pn = idx & 31, h = idx >> 5;
        u.a = (const char*)(ws + WS_WQK) + ((size_t)layer * D_ + h * 256) * D_ * 2; u.b = (const char*)(ws + WS_XN) + (size_t)pn * TILE_BYTES(D_);
        u.kind = K_SCORES; u.i0 = 0; u.i1 = pn * 256; u.i2 = h;
    }
};
struct DecWqk {
    unsigned char* ws;
    __device__ __forceinline__ void decode(int idx, Unit& u) const {
        const int l = idx >> 6, h = (idx >> 3) & 7, pn = idx & 7;
        u.a = (const char*)(ws + WS_KBD) + (size_t)l * 65536 * 2; u.b = (const char*)(ws + WS_WQ_T) + ((size_t)l * D_ + pn * 256) * D_ * 2 + (size_t)h * 512;
        u.kind = K_WQK; u.i0 = 0; u.i1 = pn * 256; u.i2 = l * D_ + h * 256;
    }
};
struct DecWcomb {
    unsigned char* ws;
    __device__ __forceinline__ void decode(int idx, Unit& u) const {
        const int l = idx >> 5, g = (idx >> 3) & 3, pm = idx & 7;
        u.a = (const char*)(ws + WS_WPO_T) + ((size_t)l * D_ + pm * 256) * PW_ * 2 + (size_t)g * 512; u.b = (const char*)(ws + WS_WPOOL) + (size_t)(l * 4 + g) * 65536 * 2;
        u.kind = K_WCOMB; u.i0 = pm * 256; u.i1 = g * 256; u.i2 = l;
    }
};
template <unsigned KINDS, class Dec> DEV void run_gemm(const Frame& F, const Dec& d, int total, int K, int lda, int ldb, const EpiAll<0xFFFFu>& e0, int c_shift = 0) {
    FlatSched<Dec> S{d, total, F.G, F.c - c_shift};
    const pg8::Epi<EpiAll<KINDS>> E{EpiAll<KINDS>{e0.ws, e0.x_in, e0.pool_scale, e0.layer, e0.ss_in, e0.ss_out, F.lds}};
    int tid = F.tid; asm volatile("" : "+v"(tid));
    pg8::gemm_phase<pg8::Epi<EpiAll<KINDS>>, FlatSched<Dec>>(F.lds, tid, pg8::Gemm{K, lda, ldb}, S, E);
}

template <int S> DEV void run_step(Frame F, int l) {
    asm volatile("" : "+s"(F.P));
    { int ln; asm volatile("v_mbcnt_lo_u32_b32 %0, -1, 0\n\tv_mbcnt_hi_u32_b32 %0, -1, %0" : "=v"(ln)); asm volatile("" : "+s"(F.wave)); F.lane = ln; F.tid = F.wave * 64 + ln; }
    asm volatile("" : "+s"(F.c), "+s"(F.G));
    unsigned char* ws = F.ws;
    if constexpr (S == 100) {
        for (int r = 0; r < REP_P0T; ++r) p0_transposes(F);
        for (int r = 0; r < REP_P0S; ++r) {
        convert_bf16(F, F.P->in[1], WSP(bf16_t, WS_P16), (size_t)2 * T_ * PLE_);
        convert_bf16(F, F.P->in[4], WSP(bf16_t, WS_WPOOL), (size_t)2 * 4 * 65536);
        for (int ll = 0; ll < 2; ++ll) convert_rows(F, F.P->in[19] + (size_t)ll * D_ * D_, WSP(bf16_t, WS_WQ_T) + (size_t)ll * D_ * D_, D_, D_, F.P->in[18] + (size_t)ll * D_);
        p0_small(F);
        p0_hdn(F);
        phase_rowstat(F, F.P->in[0], WSP(bf16_t, WS_XN), WSP(ss_t, WS_SS));
        }
    } else if constexpr (S == 102) {
        phase_final_norm(F, WSP(bf16_t, WS_HB1), F.P->in[27], F.out);
    } else {
        const float* hin = (l == 0) ? F.P->in[0] : WSP(float, WS_H);
        ss_t* SS = WSP(ss_t, WS_SS);
        const int ssi = (S == 1) ? 3 * l : (S == 8) ? 3 * l + 1 : 3 * l + 2, sso = (S == 6) ? 3 * l + 1 : 3 * l + 3;
        const EpiAll<0xFFFFu> E{ws, hin, F.P->in[5] + (size_t)l * PW_, l, SS + (size_t)ssi * T_, SS + (size_t)(sso > 6 ? 6 : sso) * T_};
        if constexpr (S == 1) {
            if (l == 0) {
                run_gemm<KM(K_FILT) | KM(K_PPROJ)>(F, DecP0b{ws}, 768, 256, 256, 256, E);
                run_gemm<KM(K_WQK)>(F, DecWqk{ws}, 128, 256, 256, D_, E);
                run_gemm<KM(K_WCOMB)>(F, DecWcomb{ws}, 64, 256, PW_, 256, E, 128);
            }
            run_gemm<KM(K_POOLIN) | KM(K_GATES) | KM(K_HYT)>(F, DecG1{ws, l}, 1024, D_, D_, D_, E);
        }
        else if constexpr (S == 2) { phase_pooldiff(F); phase_hyena(F, l); }
        else if constexpr (S == 4) { phase_z2_transpose(F);
            run_gemm<KM(K_AG)>(F, DecSimple{(const char*)(ws + WS_PD), (const char*)(ws + WS_WCOMB) + (size_t)l * D_ * PW_ * 2, PW_, PW_, 32, K_AG, 0, 256}, 256, PW_, PW_, PW_, E); }
        else if constexpr (S == 5) run_gemm<KM(K_MIX)>(F, DecSimple{(const char*)(ws + WS_Z2), (const char*)(ws + WS_WHO_T) + (size_t)l * D_ * HW_ * 2, HW_, HW_, 32, K_MIX, 0, 256}, 256, HW_, HW_, HW_, E);
        else if constexpr (S == 6) run_gemm<KM(K_RES)>(F, DecSimple{(const char*)(ws + WS_MIX), (const char*)(ws + WS_WO_T) + (size_t)l * D_ * D_ * 2, D_, D_, 32, K_RES, 0, 256}, 256, D_, D_, D_, E);
        else if constexpr (S == 8) { run_gemm<KM(K_SCORES)>(F, DecScores{ws, l}, 256, D_, D_, D_, E); phase_topk(F); }
        else if constexpr (S == 11) phase_peer_u<true, false>(F, l);
        else if constexpr (S == 17) phase_peer_u<false, false>(F, l);
        else if constexpr (S == 14) phase_peer_act(F, l);
        else if constexpr (S == 15) phase_peer_v<true>(F, l);
        else if constexpr (S == 16) phase_peer_v<false>(F, l);
        else if constexpr (S == 13) run_gemm<KM(K_PLE)>(F, DecSimple{(const char*)(ws + WS_XN), (const char*)(ws + WS_WG_T) + (size_t)l * D_ * D_ * 2, D_, D_, 32, K_PLE, 0, 256}, 256, D_, D_, D_, E);
    }
}

template <int S> __global__ void __launch_bounds__(NTHREADS, 2) mk_step(Params p) {
    extern __shared__ __attribute__((aligned(16))) unsigned char lds_raw[];
    Frame F{(LAS unsigned char*)lds_raw, (int)threadIdx.x, (int)(threadIdx.x & 63), __builtin_amdgcn_readfirstlane((int)(threadIdx.x >> 6)), (int)blockIdx.x, (int)gridDim.x, (const __attribute__((address_space(4))) Params*)__builtin_amdgcn_kernarg_segment_ptr(), p.out, p.ws};
    run_step<S>(F, p.layer);
}


#if MK_ONE_LAUNCH
__device__ unsigned g_xbar[2 * XCD_BAR_WORDS];
__device__ unsigned g_xepoch;
__global__ void __launch_bounds__(NTHREADS, 2) mk_fwd(Params p) {
    extern __shared__ __attribute__((aligned(16))) unsigned char lds_raw[];
    Frame F{(LAS unsigned char*)lds_raw, (int)threadIdx.x, (int)(threadIdx.x & 63), __builtin_amdgcn_readfirstlane((int)(threadIdx.x >> 6)), (int)blockIdx.x, (int)gridDim.x, (const __attribute__((address_space(4))) Params*)__builtin_amdgcn_kernarg_segment_ptr(), p.out, p.ws};
    volatile LAS unsigned* st = (volatile LAS unsigned*)(F.lds + LDS_BYTES - 16);
    if (F.tid == 0) { st[0] = 0u; st[1] = 0u; st[2] = 0u; st[3] = 0u; }
    __syncthreads();
    const unsigned ep = (unsigned)__builtin_amdgcn_readfirstlane((int)__hip_atomic_load(&g_xepoch, __ATOMIC_RELAXED, __HIP_MEMORY_SCOPE_AGENT));
    const XcdBarrier bar = xcd_barrier_post(g_xbar + (ep & 1u) * XCD_BAR_WORDS, st);
#define SEAM() xcd_barrier(bar)
#define RUN(S, l, R) do { if ((R) == 1) { run_step<S>(F, l); SEAM(); } else if ((R) > 1) { _Pragma("unroll 1") for (int _r = 0; _r < (R); ++_r) { run_step<S>(F, l); SEAM(); } } } while (0)
#define LAYER(l) do { RUN(1, l, REP_G1); RUN(2, l, REP_HY); RUN(4, l, REP_GS); RUN(5, l, REP_GS); RUN(6, l, 1); RUN(8, l, REP_GQ); \
        RUN(17, l, REP_PUD - 1); RUN(11, l, REP_PU); RUN(14, l, 1); RUN(16, l, REP_PV - 1); RUN(15, l, 1); RUN(13, l, 1); } while (0)
    RUN(100, 0, REP_P0);
    if (F.c == 0) { unsigned* other = g_xbar + ((ep & 1u) ^ 1u) * XCD_BAR_WORDS;
        for (int i = (int)threadIdx.x; i < XCD_BAR_WORDS; i += NTHREADS) other[i] = 0u;
        if (threadIdx.x == 0) __hip_atomic_store(&g_xepoch, ep + 1u, __ATOMIC_RELAXED, __HIP_MEMORY_SCOPE_AGENT); }
    LAYER(0);
    LAYER(1);
    run_step<102>(F, 0);
#undef SEAM
}
#endif

template <int S> static bool launch_step(Params& p, int layer, int grid, hipStream_t stream) {
    static bool attr = false;
    if (!attr) { if (hipFuncSetAttribute((const void*)mk_step<S>, hipFuncAttributeMaxDynamicSharedMemorySize, LDS_BYTES) != hipSuccess) { fprintf(stderr, "kernel_launch: hipFuncSetAttribute failed (step %d)\n", S); return false; } attr = true; }
    p.layer = layer;
    hipLaunchKernelGGL(mk_step<S>, dim3(grid), dim3(NTHREADS), LDS_BYTES, stream, p);
    return true;
}

extern "C" void kernel_launch(void* const* d_in, const int* in_sizes, int n_in, void* d_out, int out_size, void* d_ws, size_t ws_size, hipStream_t stream) {
    static int grid = 0;
    if (grid == 0) {
        if (n_in != 28 || out_size != T_ * D_ || ws_size < WS_END2) { fprintf(stderr, "kernel_launch: unexpected shapes (n_in %d, out %d, ws %zu, need %zu)\n", n_in, out_size, ws_size, (size_t)WS_END2); grid = -1; return; }
        int dev = 0, cus = 0;
        (void)hipGetDevice(&dev); (void)hipDeviceGetAttribute(&cus, hipDeviceAttributeMultiprocessorCount, dev);
        if (cus != 256) fprintf(stderr, "kernel_launch: built for a 256-CU device (one workgroup per CU, unit maps of 256); this device reports %d\n", cus);
        grid = 256;
    }
    if (grid < 0) return;
    Params p{};
    for (int i = 0; i < 28; ++i) p.in[i] = (const float*)d_in[i];
    p.out = (float*)d_out; p.ws = (unsigned char*)d_ws;
#if MK_ONE_LAUNCH
    static bool attr = false;
    if (!attr) { if (hipFuncSetAttribute((const void*)mk_fwd, hipFuncAttributeMaxDynamicSharedMemorySize, LDS_BYTES) != hipSuccess) { fprintf(stderr, "kernel_launch: hipFuncSetAttribute failed\n"); return; } attr = true; }
    hipLaunchKernelGGL(mk_fwd, dim3(grid), dim3(NTHREADS), LDS_BYTES, stream, p);
#else
    launch_step<100>(p, 0, grid, stream);
    for (int l = 0; l < DEPTH_; ++l) {
        launch_step<1>(p, l, grid, stream); launch_step<2>(p, l, grid, stream); launch_step<4>(p, l, grid, stream);
        launch_step<5>(p, l, grid, stream); launch_step<6>(p, l, grid, stream); launch_step<8>(p, l, grid, stream);
        launch_step<11>(p, l, grid, stream); launch_step<14>(p, l, grid, stream); launch_step<15>(p, l, grid, stream);
        launch_step<13>(p, l, grid, stream);
    }
    launch_step<102>(p, 0, grid, stream);
#endif
}
```
